# Optimizing an MI355X kernel written in HIP

```python
import math
import numpy as np
import jax
import jax.numpy as jnp
from jax import lax

D_MODEL = 1024
BATCH = 2
SEQ = 8192
DEPTH = 2

CTX_LEN = 256
GRID_W = 64
N_MOD = 6
BRANCH_WIDTH = 512
N_BRANCHES = 4
S5_GROUP = 16
S5_GROUPS = BRANCH_WIDTH // S5_GROUP
S5_STATE = 64
S5_DT_MIN = 0.001
S5_DT_MAX = 0.1
NA_HEADS = 8
NA_HEAD_DIM = BRANCH_WIDTH // NA_HEADS
NA_ROWS = 8
NA_COLS = 16
ML_HEADS = 4
ML_HEAD_DIM = BRANCH_WIDTH // ML_HEADS
ML_CHUNK = 128
GQ_HEADS = 8
GQ_KV_HEADS = 2
GQ_HEAD_DIM = BRANCH_WIDTH // GQ_HEADS
GQ_KV_WIDTH = GQ_KV_HEADS * GQ_HEAD_DIM
GQ_BLOCK = 128
ROPE_THETA = 10000.0
N_EXPERTS = 32
N_EXPERT_GROUPS = 8
EXPERTS_PER_GROUP = N_EXPERTS // N_EXPERT_GROUPS
TOP_K = 2
D_EXPERT = 512
MOE_BLOCK = 128
EPS = 1e-6
NEG_INIT = -1e30
F32 = jnp.float32
PROJ_SIZES = (BRANCH_WIDTH,) * 8 + (4 * ML_HEADS, BRANCH_WIDTH, GQ_KV_WIDTH, GQ_KV_WIDTH)
PROJ_WIDTH = 9 * BRANCH_WIDTH + 4 * ML_HEADS + 2 * GQ_KV_WIDTH

kernel_name = 'hybrid_prefix_diffusion_block'


def rms_norm(x, g):
    x32 = x.astype(F32)
    y = x32 * lax.rsqrt(jnp.mean(x32 * x32, axis=-1, keepdims=True) + EPS)
    return (y * g.astype(F32)).astype(x.dtype)


def modulate(x, shift, scale):
    return x * (1 + scale) + shift


def flip_seq(t, rev):
    return t[:, ::-1] if rev else t


def split_proj(p):
    idx = np.cumsum(PROJ_SIZES)[:-1].tolist()
    return jnp.split(p, idx, axis=-1)


def dense_attn(q, k, v):
    b, nq, h, dh = q.shape
    hkv = k.shape[2]
    qg = q.reshape(b, nq, hkv, h // hkv, dh)
    s = jnp.einsum('bqkgd,bskd->bkgqs', qg, k).astype(F32) * (dh ** -0.5)
    p = jax.nn.softmax(s, axis=-1)
    o = jnp.einsum('bkgqs,bskd->bqkgd', p, v.astype(F32))
    return o.reshape(b, nq, h * dh).astype(q.dtype)


def rope_1d(x, pos):
    half = x.shape[-1] // 2
    freqs = ROPE_THETA ** (-jnp.arange(half, dtype=F32) / half)
    ang = pos.astype(F32)[:, None] * freqs
    cos = jnp.cos(ang)[:, None, :]
    sin = jnp.sin(ang)[:, None, :]
    x = x.astype(F32)
    x1, x2 = x[..., :half], x[..., half:]
    return jnp.concatenate([x1 * cos - x2 * sin, x1 * sin + x2 * cos], axis=-1)


def rope_2d(x, rows, cols):
    half = x.shape[-1] // 2
    out = jnp.concatenate([rope_1d(x[..., :half], rows), rope_1d(x[..., half:], cols)], axis=-1)
    return out.astype(x.dtype)


def s5_discretize(lam_re, lam_im, log_dt, b_re, b_im):
    lam_re, lam_im = lam_re.astype(F32), lam_im.astype(F32)
    b_re, b_im = b_re.astype(F32), b_im.astype(F32)
    dt = jnp.exp(log_dt.astype(F32))[:, None]
    mag = jnp.exp(lam_re * dt)
    a_re = mag * jnp.cos(lam_im * dt)
    a_im = mag * jnp.sin(lam_im * dt)
    den = lam_re * lam_re + lam_im * lam_im
    nr = a_re - 1.0
    f_re = (nr * lam_re + a_im * lam_im) / den
    f_im = (a_im * lam_re - nr * lam_im) / den
    bb_re = f_re[..., None] * b_re - f_im[..., None] * b_im
    bb_im = f_re[..., None] * b_im + f_im[..., None] * b_re
    return a_re, a_im, bb_re, bb_im


def complex_affine_combine(e1, e2):
    a1r, a1i, b1r, b1i = e1
    a2r, a2i, b2r, b2i = e2
    return (a2r * a1r - a2i * a1i, a2r * a1i + a2i * a1r,
            a2r * b1r - a2i * b1i + b2r, a2r * b1i + a2i * b1r + b2i)


def s5_scan(u, a_re, a_im, bb_re, bb_im, h0_re, h0_im):
    xr = jnp.einsum('gpc,bngc->bngp', bb_re, u)
    xi = jnp.einsum('gpc,bngc->bngp', bb_im, u)
    xr = xr.at[:, 0].add(a_re * h0_re - a_im * h0_im)
    xi = xi.at[:, 0].add(a_re * h0_im + a_im * h0_re)
    n = u.shape[1]
    ar = jnp.broadcast_to(a_re, (1, n) + a_re.shape)
    ai = jnp.broadcast_to(a_im, (1, n) + a_im.shape)
    _, _, hr, hi = lax.associative_scan(complex_affine_combine, (ar, ai, xr, xi), axis=1)
    return hr, hi


def s5_readout(hr, hi, c_re, c_im):
    y = (jnp.einsum('gcp,bngp->bngc', c_re.astype(F32), hr)
         - jnp.einsum('gcp,bngp->bngc', c_im.astype(F32), hi))
    return y.reshape(y.shape[0], y.shape[1], -1)


def s5_glu(y, w_glu, b_glu):
    z = jax.nn.gelu(y)
    return z * jax.nn.sigmoid(z @ w_glu.astype(F32) + b_glu.astype(F32))


def s5_branch(u, uc, lam_re, lam_im, log_dt, b_re, b_im, c_re, c_im, d_skip, w_glu, b_glu, with_ctx):
    b, n_lat, _ = u.shape
    u32, uc32 = u.astype(F32), uc.astype(F32)
    ug = u32.reshape(b, n_lat, S5_GROUPS, S5_GROUP)
    ucg = uc32.reshape(b, uc.shape[1], S5_GROUPS, S5_GROUP)
    zero = jnp.zeros((b, S5_GROUPS, S5_STATE), F32)
    d32 = d_skip.astype(F32)
    y = d32 * u32
    yc = d32 * uc32 if with_ctx else None
    for d in range(2):
        rev = d == 1
        a_re, a_im, bb_re, bb_im = s5_discretize(lam_re[d], lam_im[d], log_dt[d], b_re[d], b_im[d])
        hcr, hci = s5_scan(flip_seq(ucg, rev), a_re, a_im, bb_re, bb_im, zero, zero)
        hr, hi = s5_scan(flip_seq(ug, rev), a_re, a_im, bb_re, bb_im, hcr[:, -1], hci[:, -1])
        y = y + flip_seq(s5_readout(hr, hi, c_re[d], c_im[d]), rev)
        if with_ctx:
            yc = yc + flip_seq(s5_readout(hcr, hci, c_re[d], c_im[d]), rev)
    out = s5_glu(y, w_glu, b_glu).astype(u.dtype)
    out_c = s5_glu(yc, w_glu, b_glu).astype(u.dtype) if with_ctx else None
    return out, out_c


def na_branch(q, k, v, qc, kc, vc, rpb, with_ctx):
    b, n_lat, _ = q.shape
    n_rows = n_lat // GRID_W
    kr = min(NA_ROWS, n_rows)
    shp = (b, n_rows, GRID_W, NA_HEADS, NA_HEAD_DIM)
    qg, kg, vg = q.reshape(shp), k.reshape(shp), v.reshape(shp)
    kcn = kc.reshape(b, kc.shape[1], NA_HEADS, NA_HEAD_DIM)
    vcn = vc.reshape(b, vc.shape[1], NA_HEADS, NA_HEAD_DIM)
    cols = jnp.arange(GRID_W)
    cstart = jnp.clip(cols - NA_COLS // 2, 0, GRID_W - NA_COLS)
    col_ok = (cols[None, :] >= cstart[:, None]) & (cols[None, :] < cstart[:, None] + NA_COLS)
    dc = jnp.clip(cols[None, :] - cols[:, None] + NA_COLS - 1, 0, 2 * NA_COLS - 2)
    rpb_c = rpb.astype(F32)[:, :, dc]
    scale = NA_HEAD_DIM ** -0.5
    n_win = kr * GRID_W

    def one_row(args):
        r, q_r = args
        rs = jnp.clip(r - kr // 2, 0, n_rows - kr)
        k_w = lax.dynamic_slice_in_dim(kg, rs, kr, axis=1)
        v_w = lax.dynamic_slice_in_dim(vg, rs, kr, axis=1)
        dr = rs + jnp.arange(kr) - r + NA_ROWS - 1
        bias = rpb_c[:, dr].transpose(0, 2, 1, 3)
        s_lat = jnp.einsum('bqhd,bkchd->bhqkc', q_r, k_w).astype(F32) * scale + bias[None]
        s_lat = jnp.where(col_ok[:, None, :], s_lat, -jnp.inf)
        s_ctx = jnp.einsum('bqhd,bjhd->bhqj', q_r, kcn).astype(F32) * scale
        s = jnp.concatenate([s_lat.reshape(b, NA_HEADS, GRID_W, n_win), s_ctx], axis=-1)
        p = jax.nn.softmax(s, axis=-1)
        p_lat = p[..., :n_win].reshape(b, NA_HEADS, GRID_W, kr, GRID_W)
        o = (jnp.einsum('bhqkc,bkchd->bqhd', p_lat, v_w.astype(F32))
             + jnp.einsum('bhqj,bjhd->bqhd', p[..., n_win:], vcn.astype(F32)))
        return o.astype(q.dtype)

    ob = lax.map(one_row, (jnp.arange(n_rows), jnp.moveaxis(qg, 1, 0)))
    y = jnp.moveaxis(ob, 0, 1).reshape(b, n_lat, BRANCH_WIDTH)
    if not with_ctx:
        return y, None
    qcn = qc.reshape(b, qc.shape[1], NA_HEADS, NA_HEAD_DIM)
    return y, dense_attn(qcn, kcn, vcn)


def mlstm_chunked(q, k, v, log_i, log_f, state):
    b, n_tok, nh, d = q.shape
    nc = n_tok // ML_CHUNK

    def chunks(t):
        return jnp.moveaxis(t.reshape((b, nc, ML_CHUNK) + t.shape[2:]), 1, 0)

    tri = jnp.tril(jnp.ones((ML_CHUNK, ML_CHUNK), dtype=bool))

    def step(carry, xs):
        c_mat, n_vec, m = carry
        qb, kb, vb, li, lf = xs
        bt = jnp.cumsum(lf, axis=1).transpose(0, 2, 1)
        lt = li.transpose(0, 2, 1)
        dmat = jnp.where(tri, bt[..., :, None] - bt[..., None, :] + lt[..., None, :], -jnp.inf)
        inter = bt + m[..., None]
        mt = jnp.maximum(inter, jnp.max(dmat, axis=-1))
        s = jnp.einsum('bthd,bshd->bhts', qb, kb) * jnp.exp(dmat - mt[..., None])
        w_inter = jnp.exp(inter - mt)
        num = (jnp.einsum('bhts,bshv->bhtv', s, vb)
               + w_inter[..., None] * jnp.einsum('bhvd,bthd->bhtv', c_mat, qb))
        den = jnp.sum(s, axis=-1) + w_inter * jnp.einsum('bhd,bthd->bht', n_vec, qb)
        h_out = num / jnp.maximum(jnp.abs(den), jnp.exp(-mt))[..., None]
        b_last = bt[..., -1]
        g = b_last[..., None] - bt + lt
        m_new = jnp.maximum(b_last + m, jnp.max(g, axis=-1))
        wg = jnp.exp(g - m_new[..., None])
        decay = jnp.exp(b_last + m - m_new)
        c_new = decay[..., None, None] * c_mat + jnp.einsum('bhs,bshv,bshd->bhvd', wg, vb, kb)
        n_new = decay[..., None] * n_vec + jnp.einsum('bhs,bshd->bhd', wg, kb)
        return (c_new, n_new, m_new), h_out.transpose(0, 2, 1, 3)

    final, hs = lax.scan(step, state, tuple(chunks(t) for t in (q, k, v, log_i, log_f)))
    return jnp.moveaxis(hs, 0, 1).reshape(b, n_tok, nh, d), final


def mlstm_branch(q, k, v, o, gt, qc, kc, vc, oc, gtc, b_gates, g_norm, with_ctx):
    def heads(t):
        return t.reshape(t.shape[0], t.shape[1], ML_HEADS, ML_HEAD_DIM).astype(F32)

    def gates(t):
        return (t.astype(F32) + b_gates.astype(F32)).reshape(t.shape[0], t.shape[1], 2, 2, ML_HEADS)

    scale = ML_HEAD_DIM ** -0.5
    lat = (heads(q), heads(k) * scale, heads(v))
    con = (heads(qc), heads(kc) * scale, heads(vc))
    g_lat, g_con = gates(gt), gates(gtc)
    b = q.shape[0]
    h_lat, h_con = [], []
    for d in range(2):
        rev = d == 1
        state0 = (jnp.zeros((b, ML_HEADS, ML_HEAD_DIM, ML_HEAD_DIM), F32),
                  jnp.zeros((b, ML_HEADS, ML_HEAD_DIM), F32),
                  jnp.full((b, ML_HEADS), NEG_INIT, F32))
        hc_d, st = mlstm_chunked(*(flip_seq(t, rev) for t in con),
                                 flip_seq(g_con[:, :, d, 0], rev),
                                 flip_seq(jax.nn.log_sigmoid(g_con[:, :, d, 1]), rev), state0)
        hl_d, _ = mlstm_chunked(*(flip_seq(t, rev) for t in lat),
                                flip_seq(g_lat[:, :, d, 0], rev),
                                flip_seq(jax.nn.log_sigmoid(g_lat[:, :, d, 1]), rev), st)
        h_lat.append(flip_seq(hl_d, rev))
        h_con.append(flip_seq(hc_d, rev))

    def readout(hs, og):
        y = rms_norm(hs[0] + hs[1], g_norm.reshape(ML_HEADS, ML_HEAD_DIM))
        y = y.reshape(y.shape[0], y.shape[1], BRANCH_WIDTH) * jax.nn.sigmoid(og.astype(F32))
        return y.astype(og.dtype)

    y = readout(h_lat, o)
    yc = readout(h_con, oc) if with_ctx else None
    return y, yc


def gqa_branch(q, k, v, qc, kc, vc, g_q, g_k, rows, cols, with_ctx):
    b, n_lat, _ = q.shape

    def split_heads(t, nh):
        return t.reshape(t.shape[0], t.shape[1], nh, GQ_HEAD_DIM)

    ql = rope_2d(rms_norm(split_heads(q, GQ_HEADS), g_q), rows, cols)
    kl = rope_2d(rms_norm(split_heads(k, GQ_KV_HEADS), g_k), rows, cols)
    kcn = rms_norm(split_heads(kc, GQ_KV_HEADS), g_k)
    vcn = split_heads(vc, GQ_KV_HEADS)
    k_all = jnp.concatenate([kl, kcn], axis=1)
    v_all = jnp.concatenate([split_heads(v, GQ_KV_HEADS), vcn], axis=1)
    nb = n_lat // GQ_BLOCK
    qb = jnp.moveaxis(ql.reshape(b, nb, GQ_BLOCK, GQ_HEADS, GQ_HEAD_DIM), 1, 0)
    ob = lax.map(lambda blk: dense_attn(blk, k_all, v_all), qb)
    y = jnp.moveaxis(ob, 0, 1).reshape(b, n_lat, BRANCH_WIDTH)
    if not with_ctx:
        return y, None
    qcn = rms_norm(split_heads(qc, GQ_HEADS), g_q)
    return y, dense_attn(qcn, kcn, vcn)


def merge_branches(h, ys, w_branch, w_gate, b_gate):
    gate = jax.nn.sigmoid((h @ w_gate + b_gate).astype(F32)).astype(h.dtype)
    gate = gate.reshape(h.shape[:-1] + (N_BRANCHES, h.shape[-1]))
    out = gate[..., 0, :] * (ys[0] @ w_branch[0])
    for i in range(1, N_BRANCHES):
        out = out + gate[..., i, :] * (ys[i] @ w_branch[i])
    return out


def mixer_layer(h, hc, rows, cols, w_in, lam_re, lam_im, log_dt, b_re, b_im, c_re, c_im, d_skip,
                w_glu, b_glu, rpb, ml_bg, ml_g, gq_gq, gq_gk, w_branch, w_gate, b_gate, w_out, with_ctx):
    (s5_u, na_q, na_k, na_v, ml_q, ml_k, ml_v, ml_o, ml_gt, gq_q, gq_k, gq_v) = split_proj(h @ w_in)
    (s5_uc, na_qc, na_kc, na_vc, ml_qc, ml_kc, ml_vc, ml_oc, ml_gtc, gq_qc, gq_kc, gq_vc) = split_proj(hc @ w_in)
    ya, ya_c = s5_branch(s5_u, s5_uc, lam_re, lam_im, log_dt, b_re, b_im, c_re, c_im, d_skip,
                         w_glu, b_glu, with_ctx)
    yb, yb_c = na_branch(na_q, na_k, na_v, na_qc, na_kc, na_vc, rpb, with_ctx)
    ym, ym_c = mlstm_branch(ml_q, ml_k, ml_v, ml_o, ml_gt, ml_qc, ml_kc, ml_vc, ml_oc, ml_gtc,
                            ml_bg, ml_g, with_ctx)
    yd, yd_c = gqa_branch(gq_q, gq_k, gq_v, gq_qc, gq_kc, gq_vc, gq_gq, gq_gk, rows, cols, with_ctx)
    y = merge_branches(h, (ya, yb, ym, yd), w_branch, w_gate, b_gate) @ w_out
    if not with_ctx:
        return y, None
    y_ctx = merge_branches(hc, (ya_c, yb_c, ym_c, yd_c), w_branch, w_gate, b_gate) @ w_out
    return y, y_ctx


def moe_ffn(h, w_router, b_router, w1, w3, w2):
    n_tok, d_model = h.shape
    s = jax.nn.sigmoid((h @ w_router).astype(F32))
    sel = s + b_router.astype(F32)
    sel_g = sel.reshape(n_tok, N_EXPERT_GROUPS, EXPERTS_PER_GROUP)
    grp_score = jnp.sum(lax.top_k(sel_g, TOP_K)[0], axis=-1)
    grp = jnp.argmax(grp_score, axis=-1)
    in_grp = jnp.take_along_axis(sel_g, grp[:, None, None], axis=1)[:, 0]
    _, local = lax.top_k(in_grp, TOP_K)
    expert = grp[:, None] * EXPERTS_PER_GROUP + local
    wts = jnp.take_along_axis(s, expert, axis=1)
    wts = wts / jnp.sum(wts, axis=-1, keepdims=True)
    n_asg = n_tok * TOP_K
    e_flat = expert.reshape(-1)
    tok = jnp.repeat(jnp.arange(n_tok), TOP_K)
    order = jnp.argsort(e_flat)
    e_s, tok_s, w_s = e_flat[order], tok[order], wts.reshape(-1)[order]
    counts = jnp.bincount(e_flat, length=N_EXPERTS)
    padded = (counts + MOE_BLOCK - 1) // MOE_BLOCK * MOE_BLOCK
    starts = jnp.cumsum(counts) - counts
    pend = jnp.cumsum(padded)
    pstarts = pend - padded
    dest = pstarts[e_s] + jnp.arange(n_asg) - starts[e_s]
    n_blocks = -(-n_asg // MOE_BLOCK) + N_EXPERTS
    buf = jnp.zeros((n_blocks * MOE_BLOCK, d_model), h.dtype).at[dest].set(h[tok_s])
    blk_expert = jnp.minimum(jnp.searchsorted(pend, jnp.arange(n_blocks) * MOE_BLOCK, side='right'),
                             N_EXPERTS - 1)

    def expert_block(args):
        xb, e = args
        return (jax.nn.silu(xb @ w1[e]) * (xb @ w3[e])) @ w2[e]

    yb = lax.map(expert_block, (buf.reshape(n_blocks, MOE_BLOCK, d_model), blk_expert))
    y_s = yb.reshape(-1, d_model)[dest]
    return jnp.zeros((n_tok, d_model), h.dtype).at[tok_s].add(w_s[:, None].astype(h.dtype) * y_s)


def setup_inputs(seed: int = 0) -> dict:
    key = jax.random.key(seed)
    ks = jax.random.split(key, 40)
    dm, bw, gs, ps = D_MODEL, BRANCH_WIDTH, S5_GROUPS, S5_STATE

    def nrm(i, shape, scale):
        return jax.random.normal(ks[i], shape, F32) * scale

    i_bias = nrm(20, (DEPTH, 2, ML_HEADS), 0.1)
    f_bias = jnp.linspace(3.0, 6.0, ML_HEADS, dtype=F32) + nrm(21, (DEPTH, 2, ML_HEADS), 0.1)
    return {
        'x': nrm(0, (BATCH, SEQ, dm), 1.0),
        'c': nrm(1, (BATCH, dm), 1.0),
        'ctx': nrm(2, (BATCH, CTX_LEN, dm), 1.0),
        'c_ctx': nrm(3, (dm,), 1.0),
        'w_mod': nrm(4, (DEPTH, dm, N_MOD * dm), 0.5 * dm ** -0.5),
        'b_mod': nrm(5, (DEPTH, N_MOD * dm), 0.01),
        'g_norm1': 1.0 + nrm(6, (DEPTH, dm), 0.02),
        'g_norm2': 1.0 + nrm(7, (DEPTH, dm), 0.02),
        'w_in': nrm(8, (DEPTH, dm, PROJ_WIDTH), dm ** -0.5),
        's5_lam_re': -0.5 + nrm(9, (DEPTH, 2, gs, ps), 0.01),
        's5_lam_im': math.pi * jnp.arange(ps, dtype=F32) + nrm(10, (DEPTH, 2, gs, ps), 0.01),
        's5_log_dt': jax.random.uniform(ks[11], (DEPTH, 2, gs), F32,
                                        math.log(S5_DT_MIN), math.log(S5_DT_MAX)),
        's5_b_re': nrm(12, (DEPTH, 2, gs, ps, S5_GROUP), (2 * S5_GROUP) ** -0.5),
        's5_b_im': nrm(13, (DEPTH, 2, gs, ps, S5_GROUP), (2 * S5_GROUP) ** -0.5),
        's5_c_re': nrm(14, (DEPTH, 2, gs, S5_GROUP, ps), ps ** -0.5),
        's5_c_im': nrm(15, (DEPTH, 2, gs, S5_GROUP, ps), ps ** -0.5),
        's5_d': nrm(16, (DEPTH, bw), 1.0),
        's5_w_glu': nrm(17, (DEPTH, bw, bw), bw ** -0.5),
        's5_b_glu': nrm(18, (DEPTH, bw), 0.01),
        'na_rpb': nrm(19, (DEPTH, NA_HEADS, 2 * NA_ROWS - 1, 2 * NA_COLS - 1), 0.1),
        'ml_b_gates': jnp.stack([i_bias, f_bias], axis=2).reshape(DEPTH, 4 * ML_HEADS),
        'ml_norm': 1.0 + nrm(22, (DEPTH, bw), 0.02),
        'gq_qnorm': 1.0 + nrm(23, (DEPTH, GQ_HEAD_DIM), 0.02),
        'gq_knorm': 1.0 + nrm(24, (DEPTH, GQ_HEAD_DIM), 0.02),
        'w_branch': nrm(25, (DEPTH, N_BRANCHES, bw, dm), bw ** -0.5),
        'w_gate': nrm(26, (DEPTH, dm, N_BRANCHES * dm), dm ** -0.5),
        'b_gate': nrm(27, (DEPTH, N_BRANCHES * dm), 0.01),
        'w_out': nrm(28, (DEPTH, dm, dm), dm ** -0.5),
        'w_router': nrm(29, (dm, N_EXPERTS), dm ** -0.5),
        'b_router': nrm(30, (N_EXPERTS,), 0.01),
        'moe_w1': nrm(31, (DEPTH, N_EXPERTS, dm, D_EXPERT), dm ** -0.5),
        'moe_w3': nrm(32, (DEPTH, N_EXPERTS, dm, D_EXPERT), dm ** -0.5),
        'moe_w2': nrm(33, (DEPTH, N_EXPERTS, D_EXPERT, dm), D_EXPERT ** -0.5),
        'g_final': 1.0 + nrm(34, (dm,), 0.02),
    }


def reference(x, c, ctx, c_ctx, w_mod, b_mod, g_norm1, g_norm2, w_in,
              s5_lam_re, s5_lam_im, s5_log_dt, s5_b_re, s5_b_im, s5_c_re, s5_c_im, s5_d, s5_w_glu, s5_b_glu,
              na_rpb, ml_b_gates, ml_norm, gq_qnorm, gq_knorm,
              w_branch, w_gate, b_gate, w_out, w_router, b_router, moe_w1, moe_w3, moe_w2, g_final):
    b, n_lat, dm = x.shape
    n_ctx = ctx.shape[1]
    t = jnp.arange(n_lat)
    rows = t // GRID_W
    cols = t % GRID_W
    for l in range(DEPTH):
        last = l == DEPTH - 1
        mod = (jax.nn.silu(c) @ w_mod[l] + b_mod[l]).reshape(b, N_MOD, 1, dm)
        modc = (jax.nn.silu(c_ctx) @ w_mod[l] + b_mod[l]).reshape(N_MOD, dm)
        h = modulate(rms_norm(x, g_norm1[l]), mod[:, 0], mod[:, 1])
        hc = modulate(rms_norm(ctx, g_norm1[l]), modc[0], modc[1])
        y, y_ctx = mixer_layer(h, hc, rows, cols, w_in[l],
                               s5_lam_re[l], s5_lam_im[l], s5_log_dt[l], s5_b_re[l], s5_b_im[l],
                               s5_c_re[l], s5_c_im[l], s5_d[l], s5_w_glu[l], s5_b_glu[l],
                               na_rpb[l], ml_b_gates[l], ml_norm[l], gq_qnorm[l], gq_knorm[l],
                               w_branch[l], w_gate[l], b_gate[l], w_out[l], not last)
        x = x + mod[:, 2] * y
        h2 = modulate(rms_norm(x, g_norm2[l]), mod[:, 3], mod[:, 4])
        if last:
            f = moe_ffn(h2.reshape(-1, dm), w_router, b_router, moe_w1[l], moe_w3[l], moe_w2[l])
            x = x + mod[:, 5] * f.reshape(b, n_lat, dm)
        else:
            ctx = ctx + modc[2] * y_ctx
            h2c = modulate(rms_norm(ctx, g_norm2[l]), modc[3], modc[4])
            f_all = moe_ffn(jnp.concatenate([h2.reshape(-1, dm), h2c.reshape(-1, dm)], axis=0),
                            w_router, b_router, moe_w1[l], moe_w3[l], moe_w2[l])
            x = x + mod[:, 5] * f_all[:b * n_lat].reshape(b, n_lat, dm)
            ctx = ctx + modc[5] * f_all[b * n_lat:].reshape(b, n_ctx, dm)
    return rms_norm(x, g_final)
```

```cpp
#include <hip/hip_runtime.h>
#include <hip/hip_bf16.h>
#include <hip/hip_cooperative_groups.h>
#include <cstdio>
#include <cstdint>
#include <cmath>
namespace cg = cooperative_groups;

#define LAS __attribute__((address_space(3)))
#define GAS __attribute__((address_space(1)))
typedef unsigned short bf16_t;
typedef short bf16x8 __attribute__((ext_vector_type(8)));
typedef short s16x4 __attribute__((ext_vector_type(4)));
typedef float f32x2 __attribute__((ext_vector_type(2)));
typedef float f32x4 __attribute__((ext_vector_type(4)));
typedef float f32x16 __attribute__((ext_vector_type(16)));
typedef unsigned u32x2 __attribute__((ext_vector_type(2)));
typedef unsigned u32x4 __attribute__((ext_vector_type(4)));

constexpr int DM = 1024, NB = 2, SEQ = 8192, CTX = 256, SB = SEQ + CTX  , RT = NB * SB  ;
constexpr int BW = 512, NTILE = RT / 256  , TPB = SB / 256  ;
constexpr int NMOD = 6;
constexpr int S5L = 32  , S5NC = SB / S5L  , S5ROWS = NB * S5NC  , S5RP = 768  ;
constexpr int MLC = 128, MLNC = SB / MLC  ;
constexpr int NEXP = 32, MOE_MAXROWS = RT * 2 + NEXP * 256  , MOE_MAXT = MOE_MAXROWS / 256  ;
constexpr float LOG2E = 1.4426950408889634f;

extern __shared__ __attribute__((aligned(16))) unsigned char lds_raw[];
constexpr int LDS_BYTES = 155648, MISC_OFF = 151552, WMAP_OFF = MISC_OFF + 1024;
__device__ __forceinline__ int otid() {
    const unsigned hw = (unsigned)__builtin_amdgcn_s_getreg((5 << 11) | 4) & 63u;
    const int w = ((const volatile LAS int*)((LAS unsigned char*)lds_raw + WMAP_OFF))[hw];
    int t = w * 64 + (int)__builtin_amdgcn_mbcnt_hi(~0u, __builtin_amdgcn_mbcnt_lo(~0u, 0u)); asm volatile("" : "+v"(t)); return t; }
__device__ __forceinline__ unsigned f2bf(float f) { unsigned u = __builtin_bit_cast(unsigned, f); return (u + 0x7fffu + ((u >> 16) & 1u)) >> 16; }
__device__ __forceinline__ unsigned pk2(float lo, float hi) { return f2bf(lo) | (f2bf(hi) << 16); }
__device__ __forceinline__ float bf2f(unsigned short b) { return __builtin_bit_cast(float, ((unsigned)b) << 16); }
__device__ __forceinline__ float bflo(unsigned w) { return __builtin_bit_cast(float, w << 16); }
__device__ __forceinline__ float bfhi(unsigned w) { return __builtin_bit_cast(float, w & 0xffff0000u); }
__device__ __forceinline__ float wave_sum(float v) {
#pragma unroll
    for (int o = 1; o < 64; o <<= 1) v += __shfl_xor(v, o);
    return v;
}
__device__ __forceinline__ float sigmoidf_(float x) { return 1.f / (1.f + __expf(-x)); }
__device__ __forceinline__ float log_sigmoidf_(float x) { return fminf(x, 0.f) - log1pf(__expf(-fabsf(x))); }
__device__ __forceinline__ float gelu_tanh(float x) { const float u = 0.7978845608028654f * (x + 0.044715f * x * x * x); return x * sigmoidf_(2.f * u); }

namespace pg8 {
constexpr int BM = 256, BK = 64, HALF = 128, HTB = HALF * BK * 2, STAGE_BYTES = 8 * HTB;
__host__ __device__ __forceinline__ int lds_byte(int r, int c) { const int st = (r >> 4) * 2 + (c >> 5), rr = r & 15, cc = c & 31, ob = rr * 64 + cc * 2; return st * 1024 + (ob ^ (((ob >> 9) & 1) << 5)); }
__host__ __device__ __forceinline__ void stage_rc(int b, int& R, int& C) { const int st = b / 1024, sb = b % 1024, swz = sb ^ (((sb >> 9) & 1) << 5); R = (st >> 1) * 16 + swz / 64; C = (st & 1) * 32 + (swz % 64) / 2; }
__host__ __device__ __forceinline__ int perm32(int rho) { const int n = rho >> 4, i = rho & 15; return 8 * (i >> 2) + 4 * n + (i & 3); }
struct Unit { int pm, pn, z, pad; long aoff, boff; };
struct Gemm { const bf16_t* A; const bf16_t* Bt; int lda, ldb, K; };
__device__ __forceinline__ unsigned cvt_pk_bf16(float lo, float hi) { unsigned r; asm volatile("v_cvt_pk_bf16_f32 %0, %1, %2" : "=v"(r) : "v"(lo), "v"(hi)); return r; }

template <class Epi, class Sched>
__device__ __forceinline__ void gemm_phase(LAS unsigned char* lds, const Gemm g, const Sched& S, const Epi& E) {
    const int tid = otid(), wid = __builtin_amdgcn_readfirstlane(tid >> 6), lane = tid & 63, wr = wid >> 2, wc = wid & 3, fr = lane & 15, fq = lane >> 4;
    const int K = g.K, nt = K / BK;
    unsigned voffA[2], voffB[2];
#pragma unroll
    for (int i = 0; i < 2; ++i) { int R, C; stage_rc(tid * 16 + i * 8192, R, C); const int Rb = (R & ~31) + perm32(R & 31);
        voffA[i] = (unsigned)(R * g.lda + C) * 2u; voffB[i] = (unsigned)(Rb * g.ldb + C) * 2u; }
    const size_t kstep = (size_t)(BK * 2);
    const size_t hstepA = (size_t)HALF * g.lda * 2, hstepB = (size_t)HALF * g.ldb * 2;
    const size_t tstepA = 2 * hstepA, tstepB = 2 * hstepB;
    const unsigned ldsw = (unsigned)wid * 1024u;
    const int aoff = lds_byte(wr * 64 + fr, fq * 8), boff = lds_byte(wc * 32 + fr, fq * 8);
#define PG8_SA(b, h) (((b) * 2 + (h)) * HTB)
#define PG8_SB(b, h) ((4 + (b) * 2 + (h)) * HTB)
#define PG8_STAGE(bufoff, gbase, voff) do { _Pragma("unroll") for (int _i = 0; _i < 2; ++_i) \
        __builtin_amdgcn_global_load_lds((const unsigned*)((const char*)(gbase) + (voff)[_i]), (LAS unsigned*)(lds + (bufoff) + ldsw + _i * 8192), 16, 0, 0); } while (0)
#define PG8_LDA(dst, b, h) do { _Pragma("unroll") for (int m = 0; m < 4; ++m) _Pragma("unroll") for (int k = 0; k < 2; ++k) dst[m][k] = *(const LAS bf16x8*)(lds + PG8_SA(b, h) + aoff + m * 2048 + k * 1024); } while (0)
#define PG8_LDB(dst, b, h) do { _Pragma("unroll") for (int n = 0; n < 2; ++n) _Pragma("unroll") for (int k = 0; k < 2; ++k) dst[n][k] = *(const LAS bf16x8*)(lds + PG8_SB(b, h) + boff + n * 2048 + k * 1024); } while (0)
#define PG8_MMA(ai, bj, At, Bt) do { __builtin_amdgcn_s_setprio(1); _Pragma("unroll") for (int m = 0; m < 4; ++m) _Pragma("unroll") for (int n = 0; n < 2; ++n) _Pragma("unroll") for (int k = 0; k < 2; ++k) \
        acc[ai][bj][m][n] = __builtin_amdgcn_mfma_f32_16x16x32_bf16(Bt[n][k], At[m][k], acc[ai][bj][m][n], 0, 0, 0); __builtin_amdgcn_s_setprio(0); } while (0)
#define PG8_WAIT_V(n) asm volatile("s_waitcnt vmcnt(" #n ")" ::: "memory")
#define PG8_WAIT_L(n) asm volatile("s_waitcnt lgkmcnt(" #n ")" ::: "memory")
#define PG8_BAR __builtin_amdgcn_s_barrier()
#define PG8_SCHED __builtin_amdgcn_sched_barrier(0)
    Unit cur, nxt; int ui = 0;
    if (!S.next(0, cur)) return;
#define PG8_UNI(u) do { (u).pm = __builtin_amdgcn_readfirstlane((u).pm); (u).pn = __builtin_amdgcn_readfirstlane((u).pn); (u).z = __builtin_amdgcn_readfirstlane((u).z); } while (0)
    PG8_UNI(cur);
    f32x4 acc[2][2][4][2];
#pragma unroll
    for (int a = 0; a < 2; ++a)
#pragma unroll
        for (int b = 0; b < 2; ++b)
#pragma unroll
            for (int m = 0; m < 4; ++m)
#pragma unroll
                for (int n = 0; n < 2; ++n) acc[a][b][m][n] = (f32x4){0.f, 0.f, 0.f, 0.f};
    bf16x8 At[4][2], B0[2][2], B1[2][2];
    const char* cA = (const char*)g.A + (size_t)cur.pm * tstepA + cur.aoff; const char* cB = (const char*)g.Bt + (size_t)cur.pn * tstepB + cur.boff;
    PG8_STAGE(PG8_SB(0, 0), cB, voffB); PG8_STAGE(PG8_SB(0, 1), cB + hstepB, voffB); PG8_STAGE(PG8_SA(0, 0), cA, voffA); PG8_STAGE(PG8_SA(0, 1), cA + hstepA, voffA);
    if (wr == 1) PG8_BAR;
    PG8_WAIT_V(2); PG8_BAR;
    PG8_STAGE(PG8_SB(1, 0), cB + kstep, voffB); PG8_STAGE(PG8_SA(1, 0), cA + kstep, voffA); PG8_STAGE(PG8_SB(1, 1), cB + hstepB + kstep, voffB);
    PG8_WAIT_V(6); PG8_BAR;
    for (;;) {
        const bool has_next = S.next(ui + 1, nxt); PG8_UNI(nxt);
        const char* nA = has_next ? (const char*)g.A + (size_t)nxt.pm * tstepA + nxt.aoff : cA; const char* nB = has_next ? (const char*)g.Bt + (size_t)nxt.pn * tstepB + nxt.boff : cB;
        for (int t = 0; t < nt; t += 2) {
            const bool last = (t == nt - 2);
            const char* a1 = cA + (size_t)(t + 1) * kstep;
            const char* a2 = last ? nA : cA + (size_t)(t + 2) * kstep; const char* b2 = last ? nB : cB + (size_t)(t + 2) * kstep;
            const char* a3 = a2 + kstep; const char* b3 = b2 + kstep;
            PG8_LDB(B0, 0, 0); PG8_LDB(B1, 0, 1); PG8_SCHED; PG8_LDA(At, 0, 0); PG8_STAGE(PG8_SA(1, 1), a1 + hstepA, voffA);
            PG8_WAIT_V(8); PG8_WAIT_L(0); PG8_BAR; PG8_MMA(0, 0, At, B0); PG8_MMA(0, 1, At, B1); PG8_BAR; PG8_SCHED;
            PG8_LDA(At, 0, 1); PG8_STAGE(PG8_SB(0, 0), b2, voffB); PG8_STAGE(PG8_SB(0, 1), b2 + hstepB, voffB); PG8_STAGE(PG8_SA(0, 0), a2, voffA);
            PG8_WAIT_V(8); PG8_WAIT_L(0); PG8_BAR; PG8_MMA(1, 0, At, B0); PG8_MMA(1, 1, At, B1); PG8_BAR; PG8_SCHED;
            PG8_LDB(B0, 1, 0); PG8_LDB(B1, 1, 1); PG8_SCHED; PG8_LDA(At, 1, 0); PG8_STAGE(PG8_SA(0, 1), a2 + hstepA, voffA);
            PG8_WAIT_V(8); PG8_WAIT_L(0); PG8_BAR; PG8_MMA(0, 0, At, B0); PG8_MMA(0, 1, At, B1); PG8_BAR; PG8_SCHED;
            PG8_LDA(At, 1, 1); PG8_STAGE(PG8_SB(1, 0), b3, voffB); PG8_STAGE(PG8_SB(1, 1), b3 + hstepB, voffB); PG8_STAGE(PG8_SA(1, 0), a3, voffA);
            PG8_WAIT_V(8); PG8_WAIT_L(0); PG8_BAR; PG8_MMA(1, 0, At, B0); PG8_MMA(1, 1, At, B1); PG8_BAR; PG8_SCHED;
        }
        if (wr == 0) PG8_BAR;
        E(acc, cur, wr, wc, fr, fq);
        if (!has_next) break;
#pragma unroll
        for (int a = 0; a < 2; ++a)
#pragma unroll
            for (int b = 0; b < 2; ++b)
#pragma unroll
                for (int m = 0; m < 4; ++m)
#pragma unroll
                    for (int n = 0; n < 2; ++n) acc[a][b][m][n] = (f32x4){0.f, 0.f, 0.f, 0.f};
        cur = nxt; cA = nA; cB = nB; ++ui;
        if (wr == 1) PG8_BAR;
    }
    PG8_WAIT_V(0);
    PG8_BAR;
#undef PG8_SA
#undef PG8_SB
#undef PG8_STAGE
#undef PG8_LDA
#undef PG8_LDB
#undef PG8_MMA
#undef PG8_WAIT_V
#undef PG8_WAIT_L
#undef PG8_BAR
#undef PG8_SCHED
#undef PG8_UNI
}
}
namespace attn_body {
using bf16 = __hip_bfloat16;
constexpr int D = 64, NW = 8, QBLK = 32, QB = QBLK * NW, KVBLK = 64;
__device__ __forceinline__ int crow(int r, int hi) { return (r & 3) + 8 * (r >> 2) + 4 * hi; }
#define SBAR() __builtin_amdgcn_sched_barrier(0)
constexpr int NSLOT = 3, SLOTB = 8192;
constexpr int LDS_K = 0, LDS_V = NSLOT * SLOTB, LDS_WS = 2 * NSLOT * SLOTB, LDS_OST = LDS_WS + NW * 64 * 4, LDS_BYTES = LDS_OST + NW * 4096;
__device__ __forceinline__ void glds16(const void* gsrc, unsigned lds_dst) { unsigned keep;
  asm volatile("s_mov_b32 %0, m0\n\ts_mov_b32 m0, %2\n\ts_nop 0\n\tglobal_load_lds_dwordx4 %1, off\n\ts_mov_b32 m0, %0" : "=&s"(keep) : "v"(gsrc), "s"(lds_dst) : "memory"); }
__device__ __forceinline__ float max3f(float a, float b, float c) { float r; asm("v_max3_f32 %0, %1, %2, %3" : "=v"(r) : "v"(a), "v"(b), "v"(c)); return r; }
__device__ __forceinline__ float max2f(float a, float b) { float r; asm("v_max_f32_e32 %0, %1, %2" : "=v"(r) : "v"(a), "v"(b)); return r; }
__device__ __forceinline__ float fadd_s(float a, float b) { float r; asm("v_add_f32_e32 %0, %1, %2" : "=v"(r) : "v"(a), "v"(b)); return r; }
__device__ __forceinline__ float fsub_s(float a, float b) { float r; asm("v_sub_f32_e32 %0, %1, %2" : "=v"(r) : "v"(a), "v"(b)); return r; }
typedef float f32x2_t __attribute__((ext_vector_type(2))); typedef __bf16 bf16x2_t __attribute__((ext_vector_type(2)));
__device__ __forceinline__ unsigned cvtpk_s(float lo, float hi) { f32x2_t v = {lo, hi}; bf16x2_t b = __builtin_convertvector(v, bf16x2_t); return __builtin_bit_cast(unsigned, b); }
#define WAIT_BAR(N) asm volatile("s_waitcnt vmcnt(" #N ") lgkmcnt(0)\n\ts_barrier" ::: "memory")
__device__ __forceinline__ void qkt(f32x16& p0, f32x16& p1, const char* Kslot, const bf16x8* qr, const f32x16& negm, int r32, int hi) {
  const char* kb = Kslot + hi * 1024 + r32 * 16;
#pragma unroll
  for (int d0 = 0; d0 < 4; ++d0) {
    const bf16x8 b0 = *reinterpret_cast<const bf16x8*>(kb + d0 * 2048);
    const bf16x8 b1 = *reinterpret_cast<const bf16x8*>(kb + d0 * 2048 + 512);
    if (d0 == 0) { p0 = __builtin_amdgcn_mfma_f32_32x32x16_bf16(b0, qr[0], negm, 0, 0, 0); p1 = __builtin_amdgcn_mfma_f32_32x32x16_bf16(b1, qr[0], negm, 0, 0, 0); }
    else { p0 = __builtin_amdgcn_mfma_f32_32x32x16_bf16(b0, qr[d0], p0, 0, 0, 0); p1 = __builtin_amdgcn_mfma_f32_32x32x16_bf16(b1, qr[d0], p1, 0, 0, 0); } }
}
typedef __attribute__((address_space(3))) const char* lds_cptr;
typedef short v4i16_t __attribute__((ext_vector_type(4)));
__device__ __forceinline__ void kload8(bf16x8* kf, lds_cptr kp) {
  kf[0] = *(const LAS bf16x8*)(kp);        kf[1] = *(const LAS bf16x8*)(kp + 512);
  kf[2] = *(const LAS bf16x8*)(kp + 2048); kf[3] = *(const LAS bf16x8*)(kp + 2560);
  kf[4] = *(const LAS bf16x8*)(kp + 4096); kf[5] = *(const LAS bf16x8*)(kp + 4608);
  kf[6] = *(const LAS bf16x8*)(kp + 6144); kf[7] = *(const LAS bf16x8*)(kp + 6656);
}
__device__ __forceinline__ void kload2(bf16x8* kf, lds_cptr kp, int j) { kf[2 * j] = *(const LAS bf16x8*)(kp + j * 2048); kf[2 * j + 1] = *(const LAS bf16x8*)(kp + j * 2048 + 512); }
__device__ __forceinline__ s16x4 vtr(lds_cptr p) { return __builtin_bit_cast(s16x4, __builtin_amdgcn_ds_read_tr16_b64_v4i16((LAS v4i16_t*)p)); }
__device__ __forceinline__ float rowmax(const f32x16& p0, const f32x16& p1) {
  float a = max3f(p0[0], p0[1], p1[0]), b = max3f(p0[2], p0[3], p1[1]); a = max3f(a, p1[2], p1[3]);
#pragma unroll
  for (int r = 4; r < 16; r += 4) { a = max3f(a, p0[r], p0[r + 1]); b = max3f(b, p0[r + 2], p0[r + 3]); a = max3f(a, p1[r], p1[r + 1]); b = max3f(b, p1[r + 2], p1[r + 3]); }
  const float m = max2f(a, b);
  auto rr = __builtin_amdgcn_permlane32_swap(__float_as_uint(m), __float_as_uint(m), false, false);
  return max2f(__uint_as_float(rr[0]), __uint_as_float(rr[1]));
}
__device__ __forceinline__ void pv(f32x16* o, int vb, bf16x8 pa0, bf16x8 pa1, bf16x8 pa2, bf16x8 pa3) {
#pragma unroll
  for (int d0 = 0; d0 < 2; ++d0) { s16x4 lo[4], hi[4];
#pragma unroll
    for (int ks = 0; ks < 4; ++ks) {
      asm volatile("ds_read_b64_tr_b16 %0,%1 offset:%c2" : "=&v"(lo[ks]) : "v"(vb), "i"(d0 * 4096 + ks * 1024) : "memory");
      asm volatile("ds_read_b64_tr_b16 %0,%1 offset:%c2" : "=&v"(hi[ks]) : "v"(vb), "i"(d0 * 4096 + ks * 1024 + 512) : "memory"); }
    asm volatile("s_waitcnt lgkmcnt(0)" ::: "memory"); SBAR();
#define PK(k) (bf16x8){lo[k][0], lo[k][1], lo[k][2], lo[k][3], hi[k][0], hi[k][1], hi[k][2], hi[k][3]}
    o[d0] = __builtin_amdgcn_mfma_f32_32x32x16_bf16(pa0, PK(0), o[d0], 0, 0, 0);
    o[d0] = __builtin_amdgcn_mfma_f32_32x32x16_bf16(pa1, PK(1), o[d0], 0, 0, 0);
    o[d0] = __builtin_amdgcn_mfma_f32_32x32x16_bf16(pa2, PK(2), o[d0], 0, 0, 0);
    o[d0] = __builtin_amdgcn_mfma_f32_32x32x16_bf16(pa3, PK(3), o[d0], 0, 0, 0);
#undef PK
  }
}
struct NoHook { static constexpr bool ON = false; __device__ __forceinline__ void operator()(f32x16&, f32x16&, int, int, int, int, float) const {} };

template <int THRL, class RS, class Hook>
__device__ __forceinline__ void attn_unit(const bf16* Qw0, int QP, const bf16* __restrict__ Kb, const bf16* __restrict__ Vb, int KP, const RS rs, const int NT, bf16* Ow0, int OP, char* shm, const Hook hook) {
  const int tid = otid(), lane = tid & 63, r32 = lane & 31, hi = lane >> 5; const int wid = __builtin_amdgcn_readfirstlane(tid >> 6);
  const bf16* Qw = Qw0 + (long)(wid * QBLK) * QP;
  const unsigned lds0 = (unsigned)(uintptr_t)shm;
  float* wsf = (float*)(shm + LDS_WS) + wid * 64;
  const bf16* ksrc = Kb + (long)lane * KP + wid * 8;
  const bf16* vsrc = Vb + (long)(16 * (wid & 3) + (lane >> 2)) * KP + (wid >> 2) * 32 + (lane & 3) * 8;
  const unsigned kdst = lds0 + LDS_K + wid * 1024, vdst = lds0 + LDS_V + wid * 1024;
#define DMA_K(t, slot) glds16(ksrc + (long)rs(t) * KP, (unsigned)__builtin_amdgcn_readfirstlane(kdst + (slot)))
#define DMA_V(t, slot) glds16(vsrc + (long)rs(t) * KP, (unsigned)__builtin_amdgcn_readfirstlane(vdst + (slot)))
  const int vb0 = (int)(lds0 + LDS_V) + ((lane >> 4) & 1) * 32 + (lane & 3) * 8 + (4 * hi + ((lane & 15) >> 2)) * 64;
  const char* Kbase = shm + LDS_K; bf16x8 kf[8];
  const lds_cptr shm3 = (lds_cptr)shm; const lds_cptr kp0 = shm3 + LDS_K + hi * 1024 + r32 * 16; const lds_cptr vp0 = shm3 + LDS_V + ((lane >> 4) & 1) * 32 + (lane & 3) * 8 + (4 * hi + ((lane & 15) >> 2)) * 64;
  DMA_K(0, 0); DMA_V(0, 0); DMA_K(1, SLOTB);
  bf16x8 qr[4];
#pragma unroll
  for (int d0 = 0; d0 < 4; ++d0) qr[d0] = *reinterpret_cast<const bf16x8*>(&Qw[(long)r32 * QP + d0 * 16 + hi * 8]);
  constexpr bool NONEGM = Hook::ON;
  float mhat = 0.f, l_reg = 0.f; f32x16 o[2]; o[0] = f32x16{}; o[1] = f32x16{}; f32x16 negm = f32x16{}; if constexpr (!NONEGM) asm volatile("" : "+v"(negm));
#define CMASK(P0, P1, t) do { if constexpr (Hook::ON) hook(P0, P1, (t), wid, r32, hi, mhat); } while (0)
  bool resc = false;
#define START(P0, P1) do { const float rm = rowmax(P0, P1); resc = false; \
    { const float dl = rm; mhat = fadd_s(mhat, dl); \
      _Pragma("unroll") for (int r = 0; r < 16; ++r) { P0[r] = fsub_s(P0[r], dl); P1[r] = fsub_s(P1[r], dl); } \
      if constexpr (!NONEGM) { _Pragma("unroll") for (int r = 0; r < 16; ++r) negm[r] = -mhat; asm volatile("" : "+v"(negm)); } } \
    _Pragma("unroll") for (int r = 0; r < 16; ++r) P0[r] = __builtin_amdgcn_exp2f(P0[r]); } while (0)
#define RESC() do { if (resc) { asm volatile("s_waitcnt lgkmcnt(0)" ::: "memory"); \
      _Pragma("unroll") for (int d_ = 0; d_ < 2; ++d_) _Pragma("unroll") for (int r = 0; r < 16; ++r) o[d_][r] *= wsf[crow(r, hi)]; } } while (0)
  f32x16 pA0, pA1, pB0, pB1;
  int sl_prev = 0, sl_cur = 0, sl_next = SLOTB;
#define ROT() do { sl_prev = sl_cur; sl_cur = sl_next; sl_next = (sl_next == (NSLOT - 1) * SLOTB) ? 0 : sl_next + SLOTB; } while (0)
  DMA_K(2, 2 * SLOTB);
  WAIT_BAR(3);
  qkt(pA0, pA1, Kbase, qr, negm, r32, hi); asm volatile("s_nop 15\n\ts_nop 7" : "+v"(pA0), "+v"(pA1)); CMASK(pA0, pA1, 0);
  START(pA0, pA1);
  _Pragma("unroll") for (int r = 0; r < 16; ++r) pA1[r] = __builtin_amdgcn_exp2f(pA1[r]);
  WAIT_BAR(0);
  DMA_K(3, 0); DMA_V(1, SLOTB);
  ROT();
  kload8(kf, kp0 + sl_cur);
  WAIT_BAR(2);
  s16x4 vlo[8], vhi[8]; u32x4 pw0, pw1, pw2, pw3;
#define PKW(P, B) cvtpk_s(P[B], P[B + 1])
#define PAF(k) __builtin_bit_cast(bf16x8, pw##k)
#define VFR(i) (bf16x8){vlo[i][0], vlo[i][1], vlo[i][2], vlo[i][3], vhi[i][0], vhi[i][1], vhi[i][2], vhi[i][3]}
#define PIN(x) asm volatile("" : "+v"(x))
#define MX3(a, b, c) __builtin_fmaxf(__builtin_fmaxf((a), (b)), (c))
#define GAPA(MF, A0, A1, A2, A3, W0, W1, PW) do { MF; sacc += A0; sacc += A1; sacc += A2; sacc += A3; PIN(sacc); W0; W1; PIN(PW); SBAR(); } while (0)
#define EX(v) __builtin_amdgcn_exp2f(v)
#define GAPB(MF, X, B) do { MF; X[B] = EX(X[B]); X[B + 1] = EX(X[B + 1]); X[B + 2] = EX(X[B + 2]); X[B + 3] = EX(X[B + 3]); PIN(X); SBAR(); } while (0)
#define VRD(i) do { vlo[i] = vtr(vp_ + (((i) >> 2) * 4096 + ((i) & 3) * 1024)); vhi[i] = vtr(vp_ + (((i) >> 2) * 4096 + ((i) & 3) * 1024 + 512)); } while (0)
#define KRD(G, j) do { if (G) { kload2(kf, kp0 + sl_next, j); SBAR(); } } while (0)
#define STEP(C0, C1, P0, P1, t, GK, GV, GL) do { SBAR(); \
    const lds_cptr vp_ = vp0 + sl_prev; \
    VRD(0); SBAR(); float sacc = (P0[0] + P0[1]); \
    GAPA(C0 = __builtin_amdgcn_mfma_f32_32x32x16_bf16(kf[0], qr[0], negm, 0, 0, 0), P0[2], P0[3], P0[4], P0[5],     pw0[0] = PKW(P0, 0), pw0[1] = PKW(P0, 2), pw0); \
    VRD(4); SBAR(); GAPA(C1 = __builtin_amdgcn_mfma_f32_32x32x16_bf16(kf[1], qr[0], negm, 0, 0, 0), P0[6], P0[7], P0[8], P0[9],     pw0[2] = PKW(P0, 4), pw0[3] = PKW(P0, 6), pw0); \
    VRD(1); SBAR(); GAPA(C0 = __builtin_amdgcn_mfma_f32_32x32x16_bf16(kf[2], qr[1], C0, 0, 0, 0),   P0[10], P0[11], P0[12], P0[13], pw1[0] = PKW(P0, 8), pw1[1] = PKW(P0, 10), pw1); \
    VRD(5); SBAR(); GAPA(C1 = __builtin_amdgcn_mfma_f32_32x32x16_bf16(kf[3], qr[1], C1, 0, 0, 0),   P0[14], P0[15], P1[0], P1[1],   pw1[2] = PKW(P0, 12), pw1[3] = PKW(P0, 14), pw1); \
    VRD(2); SBAR(); GAPA(C0 = __builtin_amdgcn_mfma_f32_32x32x16_bf16(kf[4], qr[2], C0, 0, 0, 0),   P1[2], P1[3], P1[4], P1[5],     pw2[0] = PKW(P1, 0), pw2[1] = PKW(P1, 2), pw2); \
    VRD(6); SBAR(); GAPA(C1 = __builtin_amdgcn_mfma_f32_32x32x16_bf16(kf[5], qr[2], C1, 0, 0, 0),   P1[6], P1[7], P1[8], P1[9],     pw2[2] = PKW(P1, 4), pw2[3] = PKW(P1, 6), pw2); \
    VRD(3); SBAR(); GAPA(C0 = __builtin_amdgcn_mfma_f32_32x32x16_bf16(kf[6], qr[3], C0, 0, 0, 0),   P1[10], P1[11], P1[12], P1[13], pw3[0] = PKW(P1, 8), pw3[1] = PKW(P1, 10), pw3); \
    VRD(7); SBAR(); GAPA(C1 = __builtin_amdgcn_mfma_f32_32x32x16_bf16(kf[7], qr[3], C1, 0, 0, 0),   P1[14], P1[15], 0.f, 0.f,       pw3[2] = PKW(P1, 12), pw3[3] = PKW(P1, 14), pw3); \
    l_reg += sacc; \
    if (GK) { DMA_K((t) + 3, sl_cur); } if (GV) { DMA_V((t) + 1, sl_next); } \
    CMASK(C0, C1, t); \
    { float a = MX3(C0[0], C0[1], C1[0]), b = MX3(C0[2], C0[3], C1[1]); a = MX3(a, C1[2], C1[3]); \
      _Pragma("unroll") for (int r = 4; r < 16; r += 4) { a = MX3(a, C0[r], C0[r + 1]); b = MX3(b, C0[r + 2], C0[r + 3]); a = MX3(a, C1[r], C1[r + 1]); b = MX3(b, C1[r + 2], C1[r + 3]); } \
      float rm = __builtin_fmaxf(a, b); { auto rr = __builtin_amdgcn_permlane32_swap(__float_as_uint(rm), __float_as_uint(rm), false, false); rm = __builtin_fmaxf(__uint_as_float(rr[0]), __uint_as_float(rr[1])); } \
      resc = false; \
      if (__builtin_expect(__any(rm > (float)THRL), 0)) { const float dl = __builtin_fmaxf(rm, 0.f); mhat += dl; \
        _Pragma("unroll") for (int r = 0; r < 16; ++r) { C0[r] -= dl; C1[r] -= dl; } \
        if constexpr (!NONEGM) { _Pragma("unroll") for (int r = 0; r < 16; ++r) negm[r] = -mhat; asm volatile("" : "+v"(negm)); } \
        const float f = __builtin_amdgcn_exp2f(-dl); l_reg *= f; if (hi == 0) wsf[r32] = f; resc = true; } } \
    SBAR(); \
    GAPB(o[0] = __builtin_amdgcn_mfma_f32_32x32x16_bf16(PAF(0), VFR(0), o[0], 0, 0, 0), C0, 0); \
    GAPB(o[1] = __builtin_amdgcn_mfma_f32_32x32x16_bf16(PAF(0), VFR(4), o[1], 0, 0, 0), C0, 4); \
    KRD(GL, 0); GAPB(o[0] = __builtin_amdgcn_mfma_f32_32x32x16_bf16(PAF(1), VFR(1), o[0], 0, 0, 0), C0, 8); \
    KRD(GL, 1); GAPB(o[1] = __builtin_amdgcn_mfma_f32_32x32x16_bf16(PAF(1), VFR(5), o[1], 0, 0, 0), C0, 12); \
    KRD(GL, 2); GAPB(o[0] = __builtin_amdgcn_mfma_f32_32x32x16_bf16(PAF(2), VFR(2), o[0], 0, 0, 0), C1, 0); \
    KRD(GL, 3); GAPB(o[1] = __builtin_amdgcn_mfma_f32_32x32x16_bf16(PAF(2), VFR(6), o[1], 0, 0, 0), C1, 4); \
    GAPB(o[0] = __builtin_amdgcn_mfma_f32_32x32x16_bf16(PAF(3), VFR(3), o[0], 0, 0, 0), C1, 8); \
    GAPB(o[1] = __builtin_amdgcn_mfma_f32_32x32x16_bf16(PAF(3), VFR(7), o[1], 0, 0, 0), C1, 12); \
    } while (0)
  int t = 1;
  for (; t + 5 < NT; t += 2) {
    STEP(pB0, pB1, pA0, pA1, t, true, true, true);     WAIT_BAR(2); RESC(); ROT();
    STEP(pA0, pA1, pB0, pB1, t + 1, true, true, true); WAIT_BAR(2); RESC(); ROT();
  }
#define ENDW(tt) do { if ((tt) + 3 < NT) { WAIT_BAR(2); } else if ((tt) + 2 < NT) { WAIT_BAR(1); } else { WAIT_BAR(0); } } while (0)
  for (; t + 1 < NT; t += 2) {
    STEP(pB0, pB1, pA0, pA1, t, (t + 3 < NT), (t + 1 < NT), (t + 1 < NT));         ENDW(t);     RESC(); ROT();
    STEP(pA0, pA1, pB0, pB1, t + 1, (t + 4 < NT), (t + 2 < NT), (t + 2 < NT));     ENDW(t + 1); RESC(); ROT();
  }
  STEP(pB0, pB1, pA0, pA1, NT - 1, false, false, false); RESC();
  { float sacc = pB0[0] + pB0[1]; _Pragma("unroll") for (int r = 2; r < 16; ++r) sacc += pB0[r]; _Pragma("unroll") for (int r = 0; r < 16; ++r) sacc += pB1[r]; l_reg += sacc;
    pw0 = (u32x4){PKW(pB0, 0), PKW(pB0, 2), PKW(pB0, 4), PKW(pB0, 6)}; pw1 = (u32x4){PKW(pB0, 8), PKW(pB0, 10), PKW(pB0, 12), PKW(pB0, 14)}; pw2 = (u32x4){PKW(pB1, 0), PKW(pB1, 2), PKW(pB1, 4), PKW(pB1, 6)}; pw3 = (u32x4){PKW(pB1, 8), PKW(pB1, 10), PKW(pB1, 12), PKW(pB1, 14)};
    SBAR(); pv(o, vb0 + sl_cur, PAF(0), PAF(1), PAF(2), PAF(3)); }
#undef PKW
#undef PAF
#undef VFR
#undef PIN
#undef MX3
#undef GAPA
#undef GAPB
#undef EX
#undef VRD
#undef KRD
#undef STEP
#undef ENDW
  { auto rr = __builtin_amdgcn_permlane32_swap(__float_as_uint(l_reg), __float_as_uint(l_reg), false, false); l_reg = __uint_as_float(rr[0]) + __uint_as_float(rr[1]); }
  if (hi == 0) wsf[32 + r32] = l_reg; asm volatile("s_waitcnt lgkmcnt(0)" ::: "memory");
  float rli[16];
#pragma unroll
  for (int r = 0; r < 16; ++r) rli[r] = __builtin_amdgcn_rcpf(wsf[32 + crow(r, hi)]);
  bf16* Ow = Ow0 + (long)(wid * QBLK) * OP;
  { bf16* stg = (bf16*)(shm + LDS_OST) + wid * 2048;
#pragma unroll
    for (int r = 0; r < 16; ++r) { const int orow = crow(r, hi);
#pragma unroll
      for (int d0 = 0; d0 < 2; ++d0) stg[orow * 64 + d0 * 32 + r32] = __float2bfloat16(o[d0][r] * rli[r]); }
    asm volatile("s_waitcnt lgkmcnt(0)" ::: "memory");
#pragma unroll
    for (int i = 0; i < 4; ++i) { const int row = i * 8 + (lane >> 3), ch = lane & 7; const u32x4 v = *(const u32x4*)(stg + row * 64 + ch * 8); *(u32x4*)(Ow + (long)row * OP + ch * 8) = v; } }
  asm volatile("s_waitcnt lgkmcnt(0)\n\ts_barrier" ::: "memory");
#undef DMA_K
#undef DMA_V
#undef CMASK
#undef START
#undef RESC
#undef ROT
}
#undef SBAR
#undef WAIT_BAR
}
#define XB_TMO      128
#define XB_XCNT(j)  (256  + 64 * (j))
#define XB_XSUB(j)  (1280 + 64 * (j))
#define XB_XGEN(j)  (2304 + 64 * (j))
#define XB_TOP      3328
#define XB_TOPGEN   3392
#define XCD_BAR_WORDS 3456
#define XB_SPIN_CAP (1u << 20)
__device__ __forceinline__ unsigned xb_ld(unsigned* p)              { return __hip_atomic_load(p, __ATOMIC_RELAXED, __HIP_MEMORY_SCOPE_AGENT); }
__device__ __forceinline__ unsigned xb_add(unsigned* p, unsigned v) { return __hip_atomic_fetch_add(p, v, __ATOMIC_RELAXED, __HIP_MEMORY_SCOPE_AGENT); }
__device__ __forceinline__ unsigned xb_xcc_id() { return (unsigned)__builtin_amdgcn_s_getreg((3 << 11) | 20) & 0xFu; }
#define XB_SPIN(cond, bar) do { unsigned _sp = 0; while (cond) { __builtin_amdgcn_s_sleep(1); \
    if ((++_sp & 255u) == 0u) { if (xb_ld(&(bar)[XB_TMO])) break; if (_sp > XB_SPIN_CAP) { atomicAdd(&(bar)[XB_TMO], 1u); break; } } } } while (0)
struct XcdBarrier { unsigned* bar; unsigned x; volatile LAS unsigned* st; };
__device__ __forceinline__ XcdBarrier xcd_barrier_post(unsigned* bar, volatile LAS unsigned* st) {
    XcdBarrier b; b.bar = bar; b.x = xb_xcc_id(); b.st = st;
    if (otid() == 0) (void)xb_add(&bar[XB_XCNT(b.x)], 1u);
    return b;
}
__device__ __forceinline__ void xcd_barrier_complete(unsigned* bar, unsigned x, unsigned& nloc, unsigned& nx) {
    const unsigned G = gridDim.x * gridDim.y * gridDim.z;
    unsigned sum, cnt, mine, sp = 0u;
    for (;;) {
        sum = 0u; cnt = 0u; mine = 0u;
#pragma unroll
        for (unsigned j = 0; j < 16; ++j) { const unsigned c = xb_ld(&bar[XB_XCNT(j)]); sum += c; cnt += (c > 0u) ? 1u : 0u; mine = (j == x) ? c : mine; }
        if (sum == G) break;
        __builtin_amdgcn_s_sleep(1);
        if ((++sp & 255u) == 0u) { if (xb_ld(&bar[XB_TMO])) break; if (sp > XB_SPIN_CAP) { atomicAdd(&bar[XB_TMO], 1u); break; } }
    }
    nloc = mine > 0u ? mine : 1u; nx = cnt > 0u ? cnt : 1u;
}
__device__ __forceinline__ void xcd_barrier(const XcdBarrier& b) {
    asm volatile("s_waitcnt vmcnt(0)" ::: "memory");
    __syncthreads();
    if (otid() == 0) {
        unsigned* bar = b.bar;
        __builtin_amdgcn_s_waitcnt(0);
        unsigned nloc = b.st[0], nx = b.st[1];
        if (nloc == 0u) { xcd_barrier_complete(bar, b.x, nloc, nx); b.st[0] = nloc; b.st[1] = nx; }
        const unsigned old = xb_add(&bar[XB_XSUB(b.x)], 1u);
        const unsigned gen = old / nloc;
        if (old + 1u == (gen + 1u) * nloc) {
            __builtin_amdgcn_fence(__ATOMIC_RELEASE, "agent");
            asm volatile("s_waitcnt vmcnt(0)" ::: "memory");
            const unsigned og = xb_add(&bar[XB_TOP], 1u);
            const unsigned tg = og / nx;
            if (og + 1u == (tg + 1u) * nx) xb_add(&bar[XB_TOPGEN], 1u);
            else XB_SPIN(xb_ld(&bar[XB_TOPGEN]) == tg, bar);
            __builtin_amdgcn_fence(__ATOMIC_ACQUIRE, "agent");
            xb_add(&bar[XB_XGEN(b.x)], 1u);
            asm volatile("s_waitcnt vmcnt(0)" ::: "memory");
        } else {
            XB_SPIN(xb_ld(&bar[XB_XGEN(b.x)]) == gen, bar);
            __builtin_amdgcn_fence(__ATOMIC_ACQUIRE, "agent");
            asm volatile("s_waitcnt vmcnt(0)" ::: "memory");
        }
    }
    __syncthreads();
}
constexpr size_t MiB = (size_t)1 << 20;
constexpr size_t WS_CTL = 0, CTL_BYTES = 1 * MiB;
constexpr size_t WS_MODV = 1 * MiB;
constexpr size_t WS_S5AL = WS_MODV + 256 * 1024;
constexpr size_t WS_ROUTE = 2 * MiB;
constexpr size_t WS_XCTX = 3 * MiB;
constexpr size_t WS_WG1 = 5 * MiB;
constexpr size_t WS_WBR = 23 * MiB;
constexpr size_t WS_WOUT = 27 * MiB;
constexpr size_t WS_WGLU = 29 * MiB;
constexpr size_t WS_S5BS = 30 * MiB;
constexpr size_t WS_S5BO = 38 * MiB;
constexpr size_t WS_HB = 62 * MiB;
constexpr size_t WS_A = 95 * MiB;
constexpr size_t WS_B = 405 * MiB;
constexpr size_t WS_C = 488 * MiB;
constexpr size_t WS_END = 540 * MiB;
constexpr size_t SZ512 = (size_t)RT * 512 * 2;
constexpr size_t A_UH = 0;
constexpr size_t A_P512 = 36 * MiB;
constexpr size_t A_GQK = A_P512 + 8 * SZ512, A_GQV = A_GQK + (size_t)RT * 128 * 2, A_MLG = A_GQV + (size_t)RT * 128 * 2;
constexpr size_t A_GATE = 178 * MiB;
constexpr size_t A_MSUM = 0;
constexpr size_t A_W13 = 0, A_W2 = 64 * MiB, A_MBUF = 96 * MiB, A_MH = 178 * MiB, A_MY = 219 * MiB;
static_assert(A_MLG + (size_t)RT * 16 * 4 <= A_GATE && A_GATE + (size_t)RT * 4096 * 2 <= 310 * MiB && A_MY + (size_t)MOE_MAXROWS * 1024 * 2 <= 310 * MiB, "region A");
constexpr size_t B_Z = 4 * SZ512;
constexpr size_t C_CST = 0, C_NST = 33 * MiB, C_DEC = C_NST + 768 * 1024, C_SST = 34 * MiB;
constexpr int CW_BAR = 4096, CW_CNT = 8192;
constexpr int NA_TAB_OFF = 86016;

__device__ __forceinline__ float* xrow_ptr(float* out, float* xctx, int row) { const int b = row / SB, s = row - b * SB; return s < CTX ? xctx + (size_t)(b * CTX + s) * DM : out + ((size_t)b * SEQ + (s - CTX)) * DM; }
__device__ __forceinline__ int modsel(int row) { const int b = row / SB, s = row - b * SB; return s < CTX ? 2 : b; }

template <class RowMap>
__device__ __forceinline__ void tr_item(const float* Wc, int ld, int k0, int nvalid, bf16_t* WT, int ldo, const RowMap rm, LAS float* scr, int lane) {
#pragma unroll 8
    for (int i = 0; i < 32; ++i) { const int kk = 2 * i + (lane >> 5), n = lane & 31; scr[kk * 33 + n] = (n < nvalid) ? Wc[(size_t)(k0 + kk) * ld + n] : 0.f; }
    asm volatile("s_waitcnt lgkmcnt(0)" ::: "memory");
    const int c = lane & 7;
#pragma unroll
    for (int j = 0; j < 4; ++j) { const int n = (lane >> 3) + 8 * j; const LAS float* s = scr + (8 * c) * 33 + n;
        u32x4 o; o.x = pk2(s[0 * 33], s[1 * 33]); o.y = pk2(s[2 * 33], s[3 * 33]); o.z = pk2(s[4 * 33], s[5 * 33]); o.w = pk2(s[6 * 33], s[7 * 33]);
        if (n < nvalid) *(u32x4*)(WT + (size_t)rm(n) * ldo + k0 + 8 * c) = o; }
    asm volatile("s_waitcnt lgkmcnt(0)" ::: "memory");
}
struct RmAffine { int r0; __device__ __forceinline__ int operator()(int n) const { return r0 + n; } };
struct RmMoe13 { int r0, n0; __device__ __forceinline__ int operator()(int n) const { const int h = n0 + n; return r0 + (h >> 2) * 8 + (h & 3); } };

__device__ __forceinline__ void conv_layer_weights(const float* w_in, const float* w_gate, const float* w_branch, const float* w_out, const float* w_glu,
                                                   unsigned char* ws, LAS float* scr, int gw, int NGW, int lane) {
    bf16_t* WG1 = (bf16_t*)(ws + WS_WG1); bf16_t* WBR = (bf16_t*)(ws + WS_WBR); bf16_t* WOUT = (bf16_t*)(ws + WS_WOUT); bf16_t* WGLU = (bf16_t*)(ws + WS_WGLU);
    constexpr int I1 = 16 * 128, I2 = 16, I3 = 16 * 24, I4 = 16 * 128, I5 = 4 * 8 * 32, I6 = 16 * 32, I7 = 8 * 16, NIT = I1 + I2 + I3 + I4 + I5 + I6 + I7;
    for (int it = gw; it < NIT; it += NGW) {
        int r = it;
        if (r < I1) { const int kb = r / 128, nb = r % 128; tr_item(w_in + 32 * nb, 4880, 64 * kb, 32, WG1, 1024, RmAffine{32 * nb}, scr, lane); continue; } r -= I1;
        if (r < I2) { tr_item(w_in + 4096, 4880, 64 * r, 16, WG1, 1024, RmAffine{4864}, scr, lane); continue; } r -= I2;
        if (r < I3) { const int kb = r / 24, nb = r % 24; tr_item(w_in + 4112 + 32 * nb, 4880, 64 * kb, 32, WG1, 1024, RmAffine{4096 + 32 * nb}, scr, lane); continue; } r -= I3;
        if (r < I4) { const int kb = r / 128, nb = r % 128; tr_item(w_gate + 32 * nb, 4096, 64 * kb, 32, WG1, 1024, RmAffine{5120 + 32 * nb}, scr, lane); continue; } r -= I4;
        if (r < I5) { const int i = r / 256, q = r % 256, kb = q / 32, nb = q % 32; tr_item(w_branch + (size_t)i * 512 * 1024 + 32 * nb, 1024, 64 * kb, 32, WBR + (size_t)i * 1024 * 512, 512, RmAffine{32 * nb}, scr, lane); continue; } r -= I5;
        if (r < I6) { const int kb = r / 32, nb = r % 32; tr_item(w_out + 32 * nb, 1024, 64 * kb, 32, WOUT, 1024, RmAffine{32 * nb}, scr, lane); continue; } r -= I6;
        { const int kb = r / 16, nb = r % 16; tr_item(w_glu + 32 * nb, 512, 64 * kb, 32, WGLU, 512, RmAffine{32 * nb}, scr, lane); }
    }
}
__device__ __forceinline__ void conv_moe_weights(const float* w1, const float* w3, const float* w2, unsigned char* ws, LAS float* scr, int gw, int NGW, int lane) {
    bf16_t* W13 = (bf16_t*)(ws + WS_A + A_W13); bf16_t* W2T = (bf16_t*)(ws + WS_A + A_W2);
    constexpr int PER = 256 + 256 + 256, NIT = 32 * PER;
    for (int it = gw; it < NIT; it += NGW) {
        const int e = it / PER; int r = it % PER;
        if (r < 256) { const int kb = r / 16, nb = r % 16; tr_item(w1 + (size_t)e * 1024 * 512 + 32 * nb, 512, 64 * kb, 32, W13, 1024, RmMoe13{e * 1024, 32 * nb}, scr, lane); continue; } r -= 256;
        if (r < 256) { const int kb = r / 16, nb = r % 16; tr_item(w3 + (size_t)e * 1024 * 512 + 32 * nb, 512, 64 * kb, 32, W13, 1024, RmMoe13{e * 1024 + 4, 32 * nb}, scr, lane); continue; } r -= 256;
        { const int kb = r / 32, nb = r % 32; tr_item(w2 + (size_t)e * 512 * 1024 + 32 * nb, 1024, 64 * kb, 32, W2T, 512, RmAffine{e * 1024 + 32 * nb}, scr, lane); }
    }
}

__device__ __forceinline__ void s5_precompute(int l, int g, const float* lam_re, const float* lam_im, const float* log_dt, const float* b_re, const float* b_im,
                                              const float* c_re, const float* c_im, const float* d_skip, unsigned char* ws, LAS unsigned char* lds) {
    const int tid = otid();
    LAS f32x2* apw = (LAS f32x2*)lds;
    LAS f32x2* bbar = (LAS f32x2*)(lds + 33792);
    LAS f32x2* ccv = (LAS f32x2*)(lds + 33792 + 16384);
    LAS float* Kt = (LAS float*)(lds + 33792 + 32768);
    float* AL = (float*)(ws + WS_S5AL);
    if (tid < 128) {
        const int d = tid >> 6, p = tid & 63; const size_t gi = ((size_t)(l * 2 + d) * 32 + g);
        const float dt = __expf(log_dt[gi]); const float lr = lam_re[gi * 64 + p], li = lam_im[gi * 64 + p];
        for (int tau = 0; tau <= 32; ++tau) { const float mag = __expf((float)tau * lr * dt), ang = (float)tau * li * dt; apw[(d * 64 + p) * 33 + tau] = (f32x2){mag * __cosf(ang), mag * __sinf(ang)}; }
        const f32x2 a = apw[(d * 64 + p) * 33 + 1]; const float nr = a.x - 1.f, den = lr * lr + li * li;
        const float fr_ = (nr * lr + a.y * li) / den, fi_ = (a.y * lr - nr * li) / den;
        for (int ch = 0; ch < 16; ++ch) { const float br = b_re[(gi * 64 + p) * 16 + ch], bi = b_im[(gi * 64 + p) * 16 + ch]; bbar[(d * 64 + p) * 16 + ch] = (f32x2){fr_ * br - fi_ * bi, fr_ * bi + fi_ * br}; }
        for (int ch = 0; ch < 16; ++ch) ccv[(d * 16 + ch) * 64 + p] = (f32x2){c_re[(gi * 16 + ch) * 64 + p], c_im[(gi * 16 + ch) * 64 + p]};
        const f32x2 a32 = apw[(d * 64 + p) * 33 + 32]; AL[((d * 32 + g) * 64 + p) * 2 + 0] = a32.x; AL[((d * 32 + g) * 64 + p) * 2 + 1] = a32.y;
    }
    __syncthreads();
    for (int e = tid; e < 2 * 32 * 256; e += 512) {
        const int d = e >> 13, tau = (e >> 8) & 31, ch = (e >> 4) & 15, c2 = e & 15; float s = 0.f;
        for (int p = 0; p < 64; ++p) { const f32x2 c = ccv[(d * 16 + ch) * 64 + p], a = apw[(d * 64 + p) * 33 + tau], bb = bbar[(d * 64 + p) * 16 + c2];
            const float car = c.x * a.x - c.y * a.y, cai = c.x * a.y + c.y * a.x; s += car * bb.x - cai * bb.y; }
        Kt[e] = s;
    }
    __syncthreads();
    bf16_t* BO = (bf16_t*)(ws + WS_S5BO) + (size_t)g * 512 * 768;
    for (int q = tid; q < 512 * 96; q += 512) {
        const int n = q / 96, k8 = (q % 96) * 8, j = n >> 4, ch = n & 15; float v[8];
        if (k8 < 512) { const int i = k8 >> 4, c0 = k8 & 15;
#pragma unroll
            for (int e = 0; e < 8; ++e) { float t = 0.f; if (j >= i) t += Kt[((0 * 32 + (j - i)) * 16 + ch) * 16 + c0 + e]; if (i >= j) t += Kt[((1 * 32 + (i - j)) * 16 + ch) * 16 + c0 + e];
                if (i == j && ch == c0 + e) t += d_skip[l * 512 + g * 16 + ch]; v[e] = t; }
        } else { const int d = (k8 >= 640) ? 1 : 0, p0 = ((k8 - 512) & 127) >> 1, tau = d ? (32 - j) : (j + 1);
#pragma unroll
            for (int e = 0; e < 4; ++e) { const f32x2 c = ccv[(d * 16 + ch) * 64 + p0 + e], a = apw[(d * 64 + p0 + e) * 33 + tau]; v[2 * e] = c.x * a.x - c.y * a.y; v[2 * e + 1] = -(c.x * a.y + c.y * a.x); }
        }
        u32x4 o; o.x = pk2(v[0], v[1]); o.y = pk2(v[2], v[3]); o.z = pk2(v[4], v[5]); o.w = pk2(v[6], v[7]);
        *(u32x4*)(BO + (size_t)n * 768 + k8) = o;
    }
    bf16_t* BS = (bf16_t*)(ws + WS_S5BS) + (size_t)g * 256 * 512;
    for (int q = tid; q < 256 * 64; q += 512) {
        const int n = q >> 6, k8 = (q & 63) * 8, d = n >> 7, p = (n >> 1) & 63, ri = n & 1, i = k8 >> 4, c0 = k8 & 15, tau = d ? i : (31 - i); float v[8];
        const f32x2 a = apw[(d * 64 + p) * 33 + tau];
#pragma unroll
        for (int e = 0; e < 8; ++e) { const f32x2 bb = bbar[(d * 64 + p) * 16 + c0 + e]; v[e] = ri ? (a.x * bb.y + a.y * bb.x) : (a.x * bb.x - a.y * bb.y); }
        u32x4 o; o.x = pk2(v[0], v[1]); o.y = pk2(v[2], v[3]); o.z = pk2(v[4], v[5]); o.w = pk2(v[6], v[7]);
        *(u32x4*)(BS + (size_t)n * 512 + k8) = o;
    }
    __syncthreads();
}

__device__ __forceinline__ void modv_item(int item, const float* w_mod, const float* b_mod, float* MODV, const LAS float* scs, int lane) {
    const int l = item / 96, col = (item % 96) * 64 + lane; const float* w = w_mod + (size_t)l * 1024 * 6144 + col;
    float a0 = 0.f, a1 = 0.f, a2 = 0.f;
#pragma unroll 8
    for (int k = 0; k < 1024; ++k) { const float wv = w[(size_t)k * 6144]; a0 += scs[k] * wv; a1 += scs[1024 + k] * wv; a2 += scs[2048 + k] * wv; }
    const float bb = b_mod[l * 6144 + col];
    MODV[(l * 3 + 0) * 6144 + col] = a0 + bb; MODV[(l * 3 + 1) * 6144 + col] = a1 + bb; MODV[(l * 3 + 2) * 6144 + col] = a2 + bb;
}

__device__ __forceinline__ void norm_mod_row(const float* xrow, const float* g, const float* shift, const float* scale, bf16_t* orow, int lane, f32x4 (&v)[4]) {
    float s = 0.f;
#pragma unroll
    for (int j = 0; j < 4; ++j) { v[j] = ((const f32x4*)xrow)[lane + 64 * j]; s += (v[j].x * v[j].x + v[j].y * v[j].y) + (v[j].z * v[j].z + v[j].w * v[j].w); }
    const float rstd = rsqrtf(wave_sum(s) * (1.f / DM) + 1e-6f);
#pragma unroll
    for (int j = 0; j < 4; ++j) { const f32x4 gg = ((const f32x4*)g)[lane + 64 * j], sh = ((const f32x4*)shift)[lane + 64 * j], sc = ((const f32x4*)scale)[lane + 64 * j];
        v[j] = (v[j] * rstd * gg) * (sc + 1.f) + sh;
        u32x2 o; o.x = pk2(v[j].x, v[j].y); o.y = pk2(v[j].z, v[j].w); ((u32x2*)orow)[lane + 64 * j] = o; }
}
struct GridOrder {
    int nM, nN, nwg, G, c, skipctx;
    __device__ __forceinline__ void init(int nM_, int nN_, int G_, int c_, int skip_) { nM = nM_; nN = nN_; nwg = nM * nN; G = G_; c = c_; skipctx = skip_; }
    __device__ __forceinline__ bool tile(long L, int& pm, int& pn) const {
        if (L >= nwg) return false;
        int wgid = (int)L; { const int q = nwg / 8, r = nwg % 8, xcd = wgid % 8, off = wgid / 8; wgid = (xcd < r ? xcd * (q + 1) : r * (q + 1) + (xcd - r) * q) + off; }
        const int nig = 8 * nN, gid = wgid / nig, fm = gid * 8, gsz = (nM - fm) < 8 ? (nM - fm) : 8;
        pm = fm + ((wgid % nig) % gsz); pn = (wgid % nig) / gsz;
        if (skipctx) pm = (pm >> 5) * 33 + 1 + (pm & 31);
        return true;
    }
    __device__ __forceinline__ bool next(int i, pg8::Unit& u) const { u.z = 0; u.pad = 0; u.aoff = 0; u.boff = 0; return tile((long)i * G + c, u.pm, u.pn); }
};
struct QuadOrder : GridOrder {
    __device__ __forceinline__ bool next(int i, pg8::Unit& u) const { u.z = i & 3; u.pad = 0; u.aoff = (long)u.z * (long)SZ512; u.boff = (long)u.z * 1024 * 512 * 2; return tile((long)(i >> 2) * G + c, u.pm, u.pn); }
};
template <int NJ> struct S5Order {
    int G, c;
    __device__ __forceinline__ bool next(int i, pg8::Unit& u) const { const int L = i * G + c; if (L >= 32 * 3 * NJ) return false; const int g = L / (3 * NJ), r = L % (3 * NJ); u.pm = 3 * g + r / NJ; u.pn = g * NJ + r % NJ; u.z = g; u.pad = 0; u.aoff = 0; u.boff = 0; return true; }
};
struct MoeOrder {
    int G, c, ntiles; const LAS int* texp;
    __device__ __forceinline__ bool next(int i, pg8::Unit& u) const { const int L = i * G + c; if (L >= ntiles * 4) return false; const int mt = L >> 2, j = L & 3; u.pm = mt; u.pn = texp[mt] * 4 + j; u.z = j; u.pad = 0; u.aoff = 0; u.boff = 0; return true; }
};

#define EPI_ARGS const f32x4 (&acc)[2][2][4][2], const pg8::Unit& u, int wr, int wc, int fr, int fq
#define EPI_LOOP_BEGIN  _Pragma("unroll") for (int ai = 0; ai < 2; ++ai) _Pragma("unroll") for (int m = 0; m < 4; ++m) { const int r = u.pm * 256 + ai * 128 + wr * 64 + m * 16 + fr; \
                        _Pragma("unroll") for (int bj = 0; bj < 2; ++bj) { const int ct = bj * 128 + wc * 32 + 8 * fq; f32x4 v0 = acc[ai][bj][m][0], v1 = acc[ai][bj][m][1];
#define EPI_LOOP_END    } }
__device__ __forceinline__ u32x4 pack8(f32x4 v0, f32x4 v1) { u32x4 w; w.x = pg8::cvt_pk_bf16(v0[0], v0[1]); w.y = pg8::cvt_pk_bf16(v0[2], v0[3]); w.z = pg8::cvt_pk_bf16(v1[0], v1[1]); w.w = pg8::cvt_pk_bf16(v1[2], v1[3]); return w; }

struct EpiG1 {
    unsigned char* ws; const float* b_gates; const float* b_gate;
    __device__ __forceinline__ void operator()(EPI_ARGS) const {
        const int pn = u.pn; unsigned char* A = ws + WS_A;
        if (pn < 2) {
            bf16_t* UH = (bf16_t*)(A + A_UH);
            EPI_LOOP_BEGIN
                const int cu = pn * 256 + ct, g = cu >> 4, ch0 = cu & 15; const int b = r / SB, s = r - b * SB, cc = s >> 5, j = s & 31;
                *(u32x4*)(UH + ((size_t)(g * S5RP + b * S5NC + cc)) * 768 + j * 16 + ch0) = pack8(v0, v1);
            EPI_LOOP_END
        } else if (pn < 18) {
            const int bi = (pn - 2) >> 1; bf16_t* P = (bf16_t*)(A + A_P512 + (size_t)bi * SZ512); const float sc = (bi == 0) ? 0.125f * LOG2E : (bi == 4 ? 0.08838834764831845f : 1.f);
            EPI_LOOP_BEGIN
                *(u32x4*)(P + (size_t)r * 512 + (pn & 1) * 256 + ct) = pack8(v0 * sc, v1 * sc);
            EPI_LOOP_END
        } else if (pn == 18) {
            EPI_LOOP_BEGIN
                bf16_t* P = (bf16_t*)(A + (bj ? A_GQV : A_GQK));
                *(u32x4*)(P + (size_t)r * 128 + wc * 32 + 8 * fq) = pack8(v0, v1);
            EPI_LOOP_END
        } else if (pn == 19) {
            float* MLG = (float*)(A + A_MLG);
            if (wc == 0 && fq < 2) {
#pragma unroll
                for (int ai = 0; ai < 2; ++ai)
#pragma unroll
                    for (int m = 0; m < 4; ++m) { const int r = u.pm * 256 + ai * 128 + wr * 64 + m * 16 + fr; f32x4 v0 = acc[ai][0][m][0], v1 = acc[ai][0][m][1];
                        const int c0 = 8 * fq;
                        v0 = v0 + *(const f32x4*)(b_gates + c0); v1 = v1 + *(const f32x4*)(b_gates + c0 + 4);
                        v1 = (f32x4){log_sigmoidf_(v1[0]), log_sigmoidf_(v1[1]), log_sigmoidf_(v1[2]), log_sigmoidf_(v1[3])};
                        *(f32x4*)(MLG + (size_t)r * 16 + c0) = v0; *(f32x4*)(MLG + (size_t)r * 16 + c0 + 4) = v1; }
            }
        } else {
            bf16_t* GT = (bf16_t*)(A + A_GATE); const int gc0 = (pn - 20) * 256;
            EPI_LOOP_BEGIN
                const int c = gc0 + ct; const f32x4 b0 = *(const f32x4*)(b_gate + c), b1 = *(const f32x4*)(b_gate + c + 4);
                v0 = v0 + b0; v1 = v1 + b1;
                v0 = (f32x4){sigmoidf_(v0[0]), sigmoidf_(v0[1]), sigmoidf_(v0[2]), sigmoidf_(v0[3])}; v1 = (f32x4){sigmoidf_(v1[0]), sigmoidf_(v1[1]), sigmoidf_(v1[2]), sigmoidf_(v1[3])};
                *(u32x4*)(GT + (size_t)r * 4096 + c) = pack8(v0, v1);
            EPI_LOOP_END
        }
    }
};
struct EpiS5State {
    float* SST;
    __device__ __forceinline__ void operator()(EPI_ARGS) const {
        const int g = u.z, mi = u.pm - 3 * g;
        EPI_LOOP_BEGIN
            const int rr = mi * 256 + (r - u.pm * 256);
            if (rr < S5ROWS) { float* p = SST + ((size_t)g * S5ROWS + rr) * 256 + ct; *(f32x4*)p = v0; *(f32x4*)(p + 4) = v1; }
        EPI_LOOP_END
    }
};
struct EpiS5Out {
    bf16_t* Z;
    __device__ __forceinline__ void operator()(EPI_ARGS) const {
        const int g = u.z, mi = u.pm - 3 * g, nj = u.pn - 2 * g;
        EPI_LOOP_BEGIN
            const int rr = mi * 256 + (r - u.pm * 256);
            if (rr < S5ROWS) { const int n = nj * 256 + ct, j = n >> 4, ch0 = n & 15, b = rr / S5NC, cc = rr - b * S5NC; const size_t row = (size_t)b * SB + cc * 32 + j;
                v0 = (f32x4){gelu_tanh(v0[0]), gelu_tanh(v0[1]), gelu_tanh(v0[2]), gelu_tanh(v0[3])}; v1 = (f32x4){gelu_tanh(v1[0]), gelu_tanh(v1[1]), gelu_tanh(v1[2]), gelu_tanh(v1[3])};
                *(u32x4*)(Z + row * 512 + g * 16 + ch0) = pack8(v0, v1); }
        EPI_LOOP_END
    }
};
struct EpiGlu {
    const bf16_t* Z; bf16_t* YA; const float* b_glu;
    __device__ __forceinline__ void operator()(EPI_ARGS) const {
        EPI_LOOP_BEGIN
            const int c = u.pn * 256 + ct; const u32x4 z = *(const u32x4*)(Z + (size_t)r * 512 + c); const f32x4 b0 = *(const f32x4*)(b_glu + c), b1 = *(const f32x4*)(b_glu + c + 4);
            v0 = v0 + b0; v1 = v1 + b1;
            v0 = (f32x4){bflo(z.x) * sigmoidf_(v0[0]), bfhi(z.x) * sigmoidf_(v0[1]), bflo(z.y) * sigmoidf_(v0[2]), bfhi(z.y) * sigmoidf_(v0[3])};
            v1 = (f32x4){bflo(z.z) * sigmoidf_(v1[0]), bfhi(z.z) * sigmoidf_(v1[1]), bflo(z.w) * sigmoidf_(v1[2]), bfhi(z.w) * sigmoidf_(v1[3])};
            *(u32x4*)(YA + (size_t)r * 512 + c) = pack8(v0, v1);
        EPI_LOOP_END
    }
};
struct EpiMerge {
    const bf16_t* GT; float* MSUM; bf16_t* HB;
    __device__ __forceinline__ void operator()(EPI_ARGS) const {
        const int z = u.z;
        EPI_LOOP_BEGIN
            const int c = u.pn * 256 + ct; const u32x4 gq = *(const u32x4*)(GT + (size_t)r * 4096 + z * 1024 + c);
            v0 = v0 * (f32x4){bflo(gq.x), bfhi(gq.x), bflo(gq.y), bfhi(gq.y)}; v1 = v1 * (f32x4){bflo(gq.z), bfhi(gq.z), bflo(gq.w), bfhi(gq.w)};
            float* mp = MSUM + (size_t)r * 1024 + c;
            if (z > 0) { v0 = v0 + *(const f32x4*)mp; v1 = v1 + *(const f32x4*)(mp + 4); }
            if (z < 3) { *(f32x4*)mp = v0; *(f32x4*)(mp + 4) = v1; } else *(u32x4*)(HB + (size_t)r * 1024 + c) = pack8(v0, v1);
        EPI_LOOP_END
    }
};
struct EpiWout {
    float* out; float* xctx; const float* modl;
    __device__ __forceinline__ void operator()(EPI_ARGS) const {
        EPI_LOOP_BEGIN
            const int c = u.pn * 256 + ct; float* xp = xrow_ptr(out, xctx, r) + c; const float* mp = modl + modsel(r) * 6144 + 2 * 1024 + c;
            const f32x4 m0 = *(const f32x4*)mp, m1 = *(const f32x4*)(mp + 4);
            *(f32x4*)xp = *(const f32x4*)xp + m0 * v0; *(f32x4*)(xp + 4) = *(const f32x4*)(xp + 4) + m1 * v1;
        EPI_LOOP_END
    }
};
struct EpiMoe1 {
    bf16_t* MH;
    __device__ __forceinline__ void operator()(EPI_ARGS) const {
        EPI_LOOP_BEGIN
            const int hcol = u.z * 128 + (ct >> 1);
            f32x4 hh = (f32x4){v0[0] * sigmoidf_(v0[0]) * v1[0], v0[1] * sigmoidf_(v0[1]) * v1[1], v0[2] * sigmoidf_(v0[2]) * v1[2], v0[3] * sigmoidf_(v0[3]) * v1[3]};
            u32x2 w; w.x = pg8::cvt_pk_bf16(hh[0], hh[1]); w.y = pg8::cvt_pk_bf16(hh[2], hh[3]);
            *(u32x2*)(MH + (size_t)r * 512 + hcol) = w;
        EPI_LOOP_END
    }
};
struct EpiMoe2 {
    bf16_t* MY;
    __device__ __forceinline__ void operator()(EPI_ARGS) const {
        EPI_LOOP_BEGIN
            *(u32x4*)(MY + (size_t)r * 1024 + u.z * 256 + ct) = pack8(v0, v1);
        EPI_LOOP_END
    }
};

constexpr int MLS = 136;
__device__ __forceinline__ void lds_gemm128(f32x4 (&acc)[2][4], const LAS bf16_t* A, const LAS bf16_t* Bt, int wm, int wn, int fr, int fq) {
#pragma unroll
    for (int ks = 0; ks < 4; ++ks) {
        bf16x8 a[2], b[4];
#pragma unroll
        for (int mi = 0; mi < 2; ++mi) a[mi] = *(const LAS bf16x8*)(A + (32 * wm + 16 * mi + fr) * MLS + ks * 32 + fq * 8);
#pragma unroll
        for (int ni = 0; ni < 4; ++ni) b[ni] = *(const LAS bf16x8*)(Bt + (64 * wn + 16 * ni + fr) * MLS + ks * 32 + fq * 8);
#pragma unroll
        for (int mi = 0; mi < 2; ++mi)
#pragma unroll
            for (int ni = 0; ni < 4; ++ni) acc[mi][ni] = __builtin_amdgcn_mfma_f32_16x16x32_bf16(a[mi], b[ni], acc[mi][ni], 0, 0, 0);
    }
}
__device__ __forceinline__ int ml_idx(int b, int d, int h, int cc) { return ((b * 2 + d) * 4 + h) * MLNC + cc; }
__device__ __forceinline__ int ml_prev(int d, int cc) { if (d == 0) return cc - 1; if (cc == 1) return -1; if (cc == 0) return 1; if (cc == 65) return 0; return cc + 1; }
__device__ __forceinline__ int ml_order(int d, int s) { if (d == 0) return s; if (s == 0) return 1; if (s == 1) return 0; return 67 - s; }

__device__ __forceinline__ float ml_gates(const float* MLG, int r0, int d, int h, LAS float* lf_s, LAS float* ev, LAS float* fs, LAS float* wv) {
    const int tid = otid(); float li = 0.f, lf = 0.f;
    if (tid < 128) { li = MLG[(size_t)(r0 + tid) * 16 + d * 8 + h]; lf = MLG[(size_t)(r0 + tid) * 16 + d * 8 + 4 + h]; lf_s[tid] = lf; }
    __syncthreads();
    float tot = 0.f;
    if (tid < 128) { float c = 0.f; for (int i = 0; i < 128; ++i) { const float x = lf_s[i]; tot += x; if (d == 0 ? (i <= tid) : (i >= tid)) c += x; }
        ev[tid] = c; fs[tid] = c - li; wv[tid] = __expf(tot - c + li); }
    __syncthreads();
    float t2 = 0.f; for (int i = 0; i < 128; ++i) t2 += lf_s[i];
    return t2;
}
__device__ __forceinline__ void ml_stage_a(int b, int h, int cc, int d, const bf16_t* MLK, const bf16_t* MLV, const float* MLG, bf16_t* CST, float* NST, float* DEC, LAS unsigned char* lds) {
    const int tid = otid(), lane = tid & 63, wid = tid >> 6, wm = wid >> 1, wn = wid & 1, fr = lane & 15, fq = lane >> 4;
    LAS bf16_t* VT = (LAS bf16_t*)lds; LAS bf16_t* KT = (LAS bf16_t*)(lds + 128 * MLS * 2);
    LAS float* lf_s = (LAS float*)(lds + 4 * 128 * MLS * 2); LAS float* ev = lf_s + 128; LAS float* fs = ev + 128; LAS float* wv = fs + 128;
    const int r0 = b * SB + cc * MLC; const int idx = ml_idx(b, d, h, cc);
    const float tot = ml_gates(MLG, r0, d, h, lf_s, ev, fs, wv);
    if (tid == 0) DEC[idx] = __expf(tot);
#pragma unroll
    for (int i = 0; i < 4; ++i) { const int q = tid + 512 * i, t = q >> 4, c8 = (q & 15) * 8;
        const u32x4 kv = *(const u32x4*)(MLK + (size_t)(r0 + t) * 512 + h * 128 + c8), vv = *(const u32x4*)(MLV + (size_t)(r0 + t) * 512 + h * 128 + c8); const float w = wv[t];
        const unsigned kk[4] = {kv.x, kv.y, kv.z, kv.w}, vw[4] = {vv.x, vv.y, vv.z, vv.w};
#pragma unroll
        for (int e = 0; e < 4; ++e) { KT[(c8 + 2 * e) * MLS + t] = (bf16_t)(kk[e] & 0xffffu); KT[(c8 + 2 * e + 1) * MLS + t] = (bf16_t)(kk[e] >> 16);
            VT[(c8 + 2 * e) * MLS + t] = (bf16_t)f2bf(bflo(vw[e]) * w); VT[(c8 + 2 * e + 1) * MLS + t] = (bf16_t)f2bf(bfhi(vw[e]) * w); } }
    __syncthreads();
    f32x4 acc[2][4];
#pragma unroll
    for (int mi = 0; mi < 2; ++mi)
#pragma unroll
        for (int ni = 0; ni < 4; ++ni) acc[mi][ni] = (f32x4){0.f, 0.f, 0.f, 0.f};
    lds_gemm128(acc, VT, KT, wm, wn, fr, fq);
    bf16_t* G = CST + (size_t)idx * 16384;
#pragma unroll
    for (int mi = 0; mi < 2; ++mi)
#pragma unroll
        for (int ni = 0; ni < 4; ++ni)
#pragma unroll
            for (int rg = 0; rg < 4; ++rg) G[(32 * wm + 16 * mi + 4 * fq + rg) * 128 + 64 * wn + 16 * ni + fr] = (bf16_t)f2bf(acc[mi][ni][rg]);
    if (tid < 128) { float s = 0.f; for (int t = 0; t < 128; ++t) s += wv[t] * bf2f(KT[tid * MLS + t]); NST[(size_t)idx * 128 + tid] = s; }
    __syncthreads();
}
__device__ __forceinline__ void ml_scan(bf16_t* CST, float* NST, const float* DEC, int gtid, int nthreads) {
    for (int q = gtid; q < 16 * 8192; q += nthreads) {
        const int seq = q >> 13, e2 = (q & 8191) * 2, b = seq >> 3, d = (seq >> 2) & 1, h = seq & 3; float s0 = 0.f, s1 = 0.f;
        for (int s = 0; s < MLNC; s += 6) { unsigned g[6]; float dc[6];
#pragma unroll
            for (int k = 0; k < 6; ++k) { const int idx = ml_idx(b, d, h, ml_order(d, s + k)); g[k] = *(const unsigned*)(CST + (size_t)idx * 16384 + e2); dc[k] = DEC[idx]; }
#pragma unroll
            for (int k = 0; k < 6; ++k) { const int idx = ml_idx(b, d, h, ml_order(d, s + k)); s0 = dc[k] * s0 + bflo(g[k]); s1 = dc[k] * s1 + bfhi(g[k]); *(unsigned*)(CST + (size_t)idx * 16384 + e2) = pk2(s0, s1); } }
    }
    for (int q = gtid; q < 16 * 128; q += nthreads) {
        const int seq = q >> 7, e = q & 127, b = seq >> 3, d = (seq >> 2) & 1, h = seq & 3; float s0 = 0.f;
        for (int s = 0; s < MLNC; ++s) { const int idx = ml_idx(b, d, h, ml_order(d, s)); s0 = DEC[idx] * s0 + NST[(size_t)idx * 128 + e]; NST[(size_t)idx * 128 + e] = s0; }
    }
}
__device__ __forceinline__ void ml_stage_c(int b, int h, int cc, const bf16_t* MLQ, const bf16_t* MLK, const bf16_t* MLV, const bf16_t* MLO, const float* MLG, const bf16_t* CST, const float* NST,
                                           const float* g_norm, bf16_t* YM, LAS unsigned char* lds) {
    const int tid = otid(), lane = tid & 63, wid = tid >> 6, wm = wid >> 1, wn = wid & 1, fr = lane & 15, fq = lane >> 4;
    LAS bf16_t* Qs = (LAS bf16_t*)lds; LAS bf16_t* Ks = (LAS bf16_t*)(lds + 128 * MLS * 2); LAS bf16_t* VT = (LAS bf16_t*)(lds + 2 * 128 * MLS * 2); LAS bf16_t* Cp = (LAS bf16_t*)(lds + 3 * 128 * MLS * 2);
    LAS float* lf_s = (LAS float*)(lds + 4 * 128 * MLS * 2); LAS float* ev = lf_s + 128; LAS float* fs = ev + 128; LAS float* wv = fs + 128; LAS float* npv = wv + 128; LAS float* den = npv + 128; LAS float* part = den + 128;
    const int r0 = b * SB + cc * MLC;
    f32x4 hsum[2][4];
#pragma unroll
    for (int mi = 0; mi < 2; ++mi)
#pragma unroll
        for (int ni = 0; ni < 4; ++ni) hsum[mi][ni] = (f32x4){0.f, 0.f, 0.f, 0.f};
    for (int d = 0; d < 2; ++d) {
        (void)ml_gates(MLG, r0, d, h, lf_s, ev, fs, wv);
        const int pc = ml_prev(d, cc); const bf16_t* Cg = (pc >= 0) ? CST + (size_t)ml_idx(b, d, h, pc) * 16384 : nullptr;
        if (tid < 128) npv[tid] = (pc >= 0) ? NST[(size_t)ml_idx(b, d, h, pc) * 128 + tid] : 0.f;
#pragma unroll
        for (int i = 0; i < 4; ++i) { const int q = tid + 512 * i, t = q >> 4, c8 = (q & 15) * 8;
            *(LAS u32x4*)(Qs + t * MLS + c8) = *(const u32x4*)(MLQ + (size_t)(r0 + t) * 512 + h * 128 + c8);
            *(LAS u32x4*)(Ks + t * MLS + c8) = *(const u32x4*)(MLK + (size_t)(r0 + t) * 512 + h * 128 + c8);
            *(LAS u32x4*)(Cp + t * MLS + c8) = Cg ? *(const u32x4*)(Cg + t * 128 + c8) : (u32x4){0u, 0u, 0u, 0u};
            const u32x4 vv = *(const u32x4*)(MLV + (size_t)(r0 + t) * 512 + h * 128 + c8); const unsigned vw[4] = {vv.x, vv.y, vv.z, vv.w};
#pragma unroll
            for (int e = 0; e < 4; ++e) { VT[(c8 + 2 * e) * MLS + t] = (bf16_t)(vw[e] & 0xffffu); VT[(c8 + 2 * e + 1) * MLS + t] = (bf16_t)(vw[e] >> 16); } }
        __syncthreads();
        f32x4 acc[2][4];
#pragma unroll
        for (int mi = 0; mi < 2; ++mi)
#pragma unroll
            for (int ni = 0; ni < 4; ++ni) acc[mi][ni] = (f32x4){0.f, 0.f, 0.f, 0.f};
        lds_gemm128(acc, Qs, Ks, wm, wn, fr, fq);
        __syncthreads();
#pragma unroll
        for (int mi = 0; mi < 2; ++mi)
#pragma unroll
            for (int ni = 0; ni < 4; ++ni) { const int s = 64 * wn + 16 * ni + fr; const float fss = fs[s];
#pragma unroll
                for (int rg = 0; rg < 4; ++rg) { const int t = 32 * wm + 16 * mi + 4 * fq + rg; const bool ok = (d == 0) ? (s <= t) : (s >= t);
                    const float p = ok ? acc[mi][ni][rg] * __expf(ev[t] - fss) : 0.f; Ks[t * MLS + s] = (bf16_t)f2bf(p); } }
#pragma unroll
        for (int i = 0; i < 4; ++i) { const int q = tid + 512 * i, t = q >> 4, c8 = (q & 15) * 8; const float sc = __expf(ev[t]);
            u32x4 qv = *(LAS u32x4*)(Qs + t * MLS + c8);
            qv.x = pk2(bflo(qv.x) * sc, bfhi(qv.x) * sc); qv.y = pk2(bflo(qv.y) * sc, bfhi(qv.y) * sc); qv.z = pk2(bflo(qv.z) * sc, bfhi(qv.z) * sc); qv.w = pk2(bflo(qv.w) * sc, bfhi(qv.w) * sc);
            *(LAS u32x4*)(Qs + t * MLS + c8) = qv; }
        __syncthreads();
        { const int t = tid >> 2, q4 = tid & 3; float s = 0.f;
            for (int j = 0; j < 32; ++j) { const int c = q4 * 32 + j; s += bf2f(Ks[t * MLS + c]) + bf2f(Qs[t * MLS + c]) * npv[c]; }
            s += __shfl_xor(s, 1); s += __shfl_xor(s, 2); if (q4 == 0) den[t] = s; }
#pragma unroll
        for (int mi = 0; mi < 2; ++mi)
#pragma unroll
            for (int ni = 0; ni < 4; ++ni) acc[mi][ni] = (f32x4){0.f, 0.f, 0.f, 0.f};
        lds_gemm128(acc, Ks, VT, wm, wn, fr, fq);
        lds_gemm128(acc, Qs, Cp, wm, wn, fr, fq);
        __syncthreads();
#pragma unroll
        for (int mi = 0; mi < 2; ++mi)
#pragma unroll
            for (int rg = 0; rg < 4; ++rg) { const int t = 32 * wm + 16 * mi + 4 * fq + rg; const float inv = 1.f / fmaxf(fabsf(den[t]), 1.f);
#pragma unroll
                for (int ni = 0; ni < 4; ++ni) hsum[mi][ni][rg] += acc[mi][ni][rg] * inv; }
        __syncthreads();
    }
#pragma unroll
    for (int mi = 0; mi < 2; ++mi)
#pragma unroll
        for (int rg = 0; rg < 4; ++rg) { float s = 0.f;
#pragma unroll
            for (int ni = 0; ni < 4; ++ni) s += hsum[mi][ni][rg] * hsum[mi][ni][rg];
            s += __shfl_xor(s, 1); s += __shfl_xor(s, 2); s += __shfl_xor(s, 4); s += __shfl_xor(s, 8);
            if (fr == 0) part[(32 * wm + 16 * mi + 4 * fq + rg) * 2 + wn] = s; }
    __syncthreads();
#pragma unroll
    for (int mi = 0; mi < 2; ++mi)
#pragma unroll
        for (int rg = 0; rg < 4; ++rg) { const int t = 32 * wm + 16 * mi + 4 * fq + rg; const float rstd = rsqrtf((part[t * 2] + part[t * 2 + 1]) * (1.f / 128.f) + 1e-6f);
#pragma unroll
            for (int ni = 0; ni < 4; ++ni) { const int c = h * 128 + 64 * wn + 16 * ni + fr; const float o = bf2f(MLO[(size_t)(r0 + t) * 512 + c]);
                YM[(size_t)(r0 + t) * 512 + c] = (bf16_t)f2bf(hsum[mi][ni][rg] * rstd * g_norm[c] * sigmoidf_(o)); } }
    __syncthreads();
}
__device__ __forceinline__ void gqa_prep_item(int row, int hs, bf16_t* GQQ, bf16_t* GQK, const float* gq, const float* gk) {
    bf16_t* p = (hs < 8) ? GQQ + (size_t)row * 512 + hs * 64 : GQK + (size_t)row * 128 + (hs - 8) * 64; const float* g = (hs < 8) ? gq : gk;
    float x[64]; float ss = 0.f;
#pragma unroll
    for (int i = 0; i < 8; ++i) { const u32x4 v = *(const u32x4*)(p + 8 * i); x[8 * i] = bflo(v.x); x[8 * i + 1] = bfhi(v.x); x[8 * i + 2] = bflo(v.y); x[8 * i + 3] = bfhi(v.y); x[8 * i + 4] = bflo(v.z); x[8 * i + 5] = bfhi(v.z); x[8 * i + 6] = bflo(v.w); x[8 * i + 7] = bfhi(v.w); }
#pragma unroll
    for (int i = 0; i < 64; ++i) ss += x[i] * x[i];
    const float rstd = rsqrtf(ss * (1.f / 64.f) + 1e-6f);
#pragma unroll
    for (int i = 0; i < 64; ++i) x[i] = x[i] * rstd * g[i];
    const int b = row / SB, s = row - b * SB;
    if (s >= CTX) { const int n = s - CTX; const float pr = (float)(n >> 6), pc = (float)(n & 63);
#pragma unroll
        for (int i = 0; i < 16; ++i) { const float fr_ = exp2f(-(float)i * (13.287712379549449f / 16.f));
            float sn, cs; __sincosf(pr * fr_, &sn, &cs); const float a1 = x[i], a2 = x[16 + i]; x[i] = a1 * cs - a2 * sn; x[16 + i] = a1 * sn + a2 * cs;
            __sincosf(pc * fr_, &sn, &cs); const float b1 = x[32 + i], b2 = x[48 + i]; x[32 + i] = b1 * cs - b2 * sn; x[48 + i] = b1 * sn + b2 * cs; } }
    const float sc = (hs < 8) ? 0.125f * LOG2E : 1.f;
#pragma unroll
    for (int i = 0; i < 8; ++i) { u32x4 o; o.x = pk2(x[8 * i] * sc, x[8 * i + 1] * sc); o.y = pk2(x[8 * i + 2] * sc, x[8 * i + 3] * sc); o.z = pk2(x[8 * i + 4] * sc, x[8 * i + 5] * sc); o.w = pk2(x[8 * i + 6] * sc, x[8 * i + 7] * sc); *(u32x4*)(p + 8 * i) = o; }
}

struct RsLinear { __device__ __forceinline__ int operator()(int t) const { return 64 * t; } };
struct RsNa { int w0; __device__ __forceinline__ int operator()(int t) const { return t < 4 ? 64 * t : CTX + 64 * (w0 + t - 4); } };
struct NaHook { static constexpr bool ON = true; const LAS float* tab; int r0, w0;
    __device__ __forceinline__ void operator()(f32x16& C0, f32x16& C1, int t, int wid, int r32, int hi, float mhat) const {
        if (t < 4) {
#pragma unroll
            for (int q = 0; q < 16; ++q) { C0[q] -= mhat; C1[q] -= mhat; }
            return; }
        const int r = r0 + (wid >> 1), c = 32 * (wid & 1) + r32, kr = w0 + t - 4;
        const int rs = min(max(r - 4, 0), 120), cs = min(max(c - 8, 0), 48);
        const float NEG = -INFINITY;
        if (kr < rs || kr >= rs + 8) {
#pragma unroll
            for (int q = 0; q < 16; ++q) { C0[q] = NEG; C1[q] = NEG; }
            return; }
        const LAS float* tl = tab + (kr - r + 7) * 31 + (15 - c) + 4 * hi; const int kb = 4 * hi - cs;
#pragma unroll
        for (int q = 0; q < 16; ++q) { const int ko = (q & 3) + 8 * (q >> 2);
            C0[q] = ((unsigned)(kb + ko) < 16u) ? C0[q] + (tl[ko] - mhat) : NEG; C1[q] = ((unsigned)(kb + ko + 32) < 16u) ? C1[q] + (tl[ko + 32] - mhat) : NEG; }
    }
};
__device__ __forceinline__ void na_phase(int l, int vcu, int G, const float* rpb_l, unsigned char* ws, char* lds) {
    const bf16_t* NAQ = (const bf16_t*)(ws + WS_A + A_P512), *NAK = NAQ + (size_t)RT * 512, *NAV = NAK + (size_t)RT * 512; bf16_t* YB = (bf16_t*)(ws + WS_B + SZ512);
    float* tabf = (float*)(lds + NA_TAB_OFF);
    for (int i = otid(); i < 8 * 465; i += 512) tabf[i] = rpb_l[i] * LOG2E;
    __syncthreads();
    const int nu = 512 + (l == 0 ? 16 : 0);
    for (int u = vcu; u < nu; u += G) {
        using bf = attn_body::bf16;
        if (u < 512) { const int b = u >> 8, h = (u >> 5) & 7, qb = u & 31; const int r0 = 4 * qb, w0 = min(max(r0 - 4, 0), 116);
            const size_t qrow = (size_t)b * SB + CTX + 256 * qb, krow = (size_t)b * SB;
            NaHook hk{(const LAS float*)(tabf + h * 465), r0, w0};
            attn_body::attn_unit<8>((const bf*)(NAQ + qrow * 512 + h * 64), 512, (const bf*)(NAK + krow * 512 + h * 64), (const bf*)(NAV + krow * 512 + h * 64), 512, RsNa{w0}, 16, (bf*)(YB + qrow * 512 + h * 64), 512, lds, hk);
        } else { const int b = (u - 512) >> 3, h = (u - 512) & 7; const size_t krow = (size_t)b * SB;
            attn_body::attn_unit<8>((const bf*)(NAQ + krow * 512 + h * 64), 512, (const bf*)(NAK + krow * 512 + h * 64), (const bf*)(NAV + krow * 512 + h * 64), 512, RsLinear{}, 4, (bf*)(YB + krow * 512 + h * 64), 512, lds, attn_body::NoHook{});
        }
    }
}
__device__ __forceinline__ void gqa_phase(int l, int vcu, int G, unsigned char* ws, char* lds) {
    const bf16_t* GQQ = (const bf16_t*)(ws + WS_A + A_P512 + 7 * SZ512), *GQK = (const bf16_t*)(ws + WS_A + A_GQK), *GQV = (const bf16_t*)(ws + WS_A + A_GQV); bf16_t* YD = (bf16_t*)(ws + WS_B + 3 * SZ512);
    const int nu = 512 + (l == 0 ? 16 : 0);
    for (int u = vcu; u < nu; u += G) {
        using bf = attn_body::bf16;
        if (u < 512) { const int hq = u & 3, qb = (u >> 2) & 31, kvh = (u >> 7) & 1, b = u >> 8, h = kvh * 4 + hq;
            const size_t qrow = (size_t)b * SB + CTX + 256 * qb, krow = (size_t)b * SB;
            attn_body::attn_unit<8>((const bf*)(GQQ + qrow * 512 + h * 64), 512, (const bf*)(GQK + krow * 128 + kvh * 64), (const bf*)(GQV + krow * 128 + kvh * 64), 128, RsLinear{}, SB / 64, (bf*)(YD + qrow * 512 + h * 64), 512, lds, attn_body::NoHook{});
        } else { const int b = (u - 512) >> 3, h = (u - 512) & 7, kvh = h >> 2; const size_t krow = (size_t)b * SB;
            attn_body::attn_unit<8>((const bf*)(GQQ + krow * 512 + h * 64), 512, (const bf*)(GQK + krow * 128 + kvh * 64), (const bf*)(GQV + krow * 128 + kvh * 64), 128, RsLinear{}, 4, (bf*)(YD + krow * 512 + h * 64), 512, lds, attn_body::NoHook{});
        }
    }
}

__device__ __forceinline__ int s5_order(int d, int s) { if (d == 0) return s; return s < 8 ? 7 - s : 271 - s; }
__device__ __forceinline__ void s5_scan(const float* SST, const float* AL, bf16_t* UH, int gtid, int nthreads) {
    for (int q = gtid; q < 2 * 2 * 32 * 64; q += nthreads) {
        const int p = q & 63, g = (q >> 6) & 31, d = (q >> 11) & 1, b = q >> 12;
        const float ar = AL[((d * 32 + g) * 64 + p) * 2], ai = AL[((d * 32 + g) * 64 + p) * 2 + 1]; float hr = 0.f, hi_ = 0.f;
        const float* sp = SST + ((size_t)g * S5ROWS + b * S5NC) * 256 + d * 128 + 2 * p; bf16_t* up = UH + ((size_t)g * S5RP + b * S5NC) * 768 + 512 + d * 128 + 2 * p;
        for (int s = 0; s < S5NC; s += 8) { f32x2 x[8];
#pragma unroll
            for (int k = 0; k < 8; ++k) x[k] = *(const f32x2*)(sp + (size_t)s5_order(d, s + k) * 256);
#pragma unroll
            for (int k = 0; k < 8; ++k) { const int cc = s5_order(d, s + k); *(unsigned*)(up + (size_t)cc * 768) = pk2(hr, hi_);
                const float nr = ar * hr - ai * hi_ + x[k].x, ni = ar * hi_ + ai * hr + x[k].y; hr = nr; hi_ = ni; } }
    }
}

__device__ __forceinline__ void route_token(const float (&lg)[32], const float* b_router, int& e0, int& e1, float& w0, float& w1) {
    float s[32], sel[32];
#pragma unroll
    for (int i = 0; i < 32; ++i) { s[i] = sigmoidf_(lg[i]); sel[i] = s[i] + b_router[i]; }
    float best = -INFINITY; int grp = 0;
#pragma unroll
    for (int gi = 0; gi < 8; ++gi) { const float a = sel[4 * gi], b = sel[4 * gi + 1], c = sel[4 * gi + 2], d = sel[4 * gi + 3];
        const float m1 = fmaxf(fmaxf(a, b), fmaxf(c, d)); const float sum = a + b + c + d, mn = fminf(fminf(a, b), fminf(c, d));
        float x0 = a, x1 = b, x2 = c, x3 = d; bool rem = false; float sec = -INFINITY;
        if (!rem && x0 == m1) rem = true; else sec = fmaxf(sec, x0);
        if (!rem && x1 == m1) rem = true; else sec = fmaxf(sec, x1);
        if (!rem && x2 == m1) rem = true; else sec = fmaxf(sec, x2);
        if (!rem && x3 == m1) rem = true; else sec = fmaxf(sec, x3);
        (void)sum; (void)mn;
        const float sc = m1 + sec; if (sc > best) { best = sc; grp = gi; } }
    float v[4]; float sv[4];
#pragma unroll
    for (int j = 0; j < 4; ++j) { v[j] = 0.f; sv[j] = 0.f; }
#pragma unroll
    for (int gi = 0; gi < 8; ++gi) if (gi == grp) {
#pragma unroll
        for (int j = 0; j < 4; ++j) { v[j] = sel[4 * gi + j]; sv[j] = s[4 * gi + j]; } }
    int i0 = 0; float m = v[0];
#pragma unroll
    for (int j = 1; j < 4; ++j) if (v[j] > m) { m = v[j]; i0 = j; }
    int i1 = -1; float m2 = -INFINITY;
#pragma unroll
    for (int j = 0; j < 4; ++j) if (j != i0 && v[j] > m2) { m2 = v[j]; i1 = j; }
    float s0 = 0.f, s1 = 0.f;
#pragma unroll
    for (int j = 0; j < 4; ++j) { if (j == i0) s0 = sv[j]; if (j == i1) s1 = sv[j]; }
    e0 = grp * 4 + i0; e1 = grp * 4 + i1; const float inv = 1.f / (s0 + s1); w0 = s0 * inv; w1 = s1 * inv;
}
__device__ __forceinline__ int moe_offsets(const unsigned* cnt, LAS int* offs, LAS int* texp) {
    if (otid() == 0) { int o = 0; for (int e = 0; e < 32; ++e) { offs[e] = o; const int c = (int)__hip_atomic_load(cnt + e, __ATOMIC_RELAXED, __HIP_MEMORY_SCOPE_AGENT); const int pt = (c + 255) >> 8; for (int t = 0; t < pt; ++t) texp[(o >> 8) + t] = e; o += pt * 256; } offs[32] = o; }
    __syncthreads();
    return offs[32] >> 8;
}
#ifndef MK_MULTI
#define MK_MULTI 1
#endif
constexpr int NPHASE = 26;
#ifndef PHMASK
#define PHMASK 0xffff
#endif
#define HAS(k) (((PHMASK) >> (k)) & 1)
#ifndef SUBMASK
#define SUBMASK 0xff
#endif
#define SUB(k) (((SUBMASK) >> (k)) & 1)
struct Args { const float* in[34]; float* out; unsigned char* ws; int ph_lo, ph_hi; };
enum { I_X = 0, I_C, I_CTX, I_CCTX, I_WMOD, I_BMOD, I_GN1, I_GN2, I_WIN, I_LAMRE, I_LAMIM, I_LOGDT, I_BRE, I_BIM, I_CRE, I_CIM, I_S5D, I_WGLU, I_BGLU, I_RPB, I_MLBG, I_MLNORM, I_GQQN, I_GQKN,
       I_WBR, I_WGATE, I_BGATE, I_WOUT, I_WROUTER, I_BROUTER, I_W1, I_W3, I_W2, I_GFINAL };

__device__ __forceinline__ void norm_mod_vals(f32x4 (&v)[4], const float* g, const float* shift, const float* scale, bf16_t* orow, int lane) {
    float s = 0.f;
#pragma unroll
    for (int j = 0; j < 4; ++j) s += (v[j].x * v[j].x + v[j].y * v[j].y) + (v[j].z * v[j].z + v[j].w * v[j].w);
    const float rstd = rsqrtf(wave_sum(s) * (1.f / DM) + 1e-6f);
#pragma unroll
    for (int j = 0; j < 4; ++j) { const f32x4 gg = ((const f32x4*)g)[lane + 64 * j], sh = ((const f32x4*)shift)[lane + 64 * j], sc = ((const f32x4*)scale)[lane + 64 * j];
        v[j] = (v[j] * rstd * gg) * (sc + 1.f) + sh;
        u32x2 o; o.x = pk2(v[j].x, v[j].y); o.y = pk2(v[j].z, v[j].w); ((u32x2*)orow)[lane + 64 * j] = o; }
}

__device__ __forceinline__ const char* kseg() { const char* ka = (const char*)__builtin_amdgcn_kernarg_segment_ptr(); asm volatile("" : "+s"(ka)); return ka; }
__device__ __forceinline__ const float* kin(int i) { return *(const float* const*)(kseg() + 8 * i); }
__device__ __forceinline__ float* kout() { return *(float* const*)(kseg() + 8 * 34); }
__device__ __forceinline__ unsigned char* kws() { return *(unsigned char* const*)(kseg() + 8 * 35); }
template <int K, int L>
__device__ __forceinline__ void run_phase(unsigned char* ws, float* out, const int vcu, const int G, const int bx, LAS unsigned char* lds, unsigned char* lds_raw) {
    const int NGW = G * 8, NTH = G * 512;
    float* xctx = (float*)(ws + WS_XCTX); unsigned* ctl = (unsigned*)(ws + WS_CTL);
    float* MODV = (float*)(ws + WS_MODV); bf16_t* HB = (bf16_t*)(ws + WS_HB);
    unsigned char* RA = ws + WS_A; unsigned char* RB = ws + WS_B; unsigned char* RC = ws + WS_C;
    LAS int* offs = (LAS int*)(lds + MISC_OFF + 64); LAS int* texp = (LAS int*)(lds + MISC_OFF + 256);
    int* TOK_E = (int*)(ws + WS_ROUTE); float* TOK_W = (float*)(ws + WS_ROUTE + (size_t)RT * 8); int* TOK_DST = (int*)(ws + WS_ROUTE + (size_t)RT * 16);
    {
        const int tid = otid(), lane = tid & 63, wave = __builtin_amdgcn_readfirstlane(tid >> 6), gw = vcu * 8 + wave, gtid = vcu * 512 + tid;
        constexpr int l = L, k = K; constexpr bool last = (l == 1);
        const float* modl = MODV + l * 3 * 6144;
        if constexpr (HAS(0) && (k == 0 || (k == 13 && l == 0))) {
            const int lc = (k == 0) ? 0 : 1;
            if (k == 0) {
                const f32x4* x4 = (const f32x4*)kin(I_X); f32x4* o4 = (f32x4*)out;
                for (int i = gtid; i < NB * SEQ * DM / 4; i += NTH) o4[i] = x4[i];
                const f32x4* c4 = (const f32x4*)kin(I_CTX); f32x4* xc4 = (f32x4*)xctx;
                for (int i = gtid; i < NB * CTX * DM / 4; i += NTH) xc4[i] = c4[i];
            } else {
                const bf16_t* MY = (const bf16_t*)(RA + A_MY);
                for (int row = gw; row < RT; row += NGW) {
                    float* xr = xrow_ptr(out, xctx, row); const int ms = modsel(row); const float* m5 = modl + ms * 6144 + 5 * 1024;
                    const int d0 = TOK_DST[row * 2], d1 = TOK_DST[row * 2 + 1]; const float w0 = TOK_W[row * 2], w1 = TOK_W[row * 2 + 1];
                    f32x4 v[4];
#pragma unroll
                    for (int j = 0; j < 4; ++j) { const u32x2 y0 = ((const u32x2*)(MY + (size_t)d0 * 1024))[lane + 64 * j], y1 = ((const u32x2*)(MY + (size_t)d1 * 1024))[lane + 64 * j];
                        const f32x4 f = (f32x4){w0 * bflo(y0.x) + w1 * bflo(y1.x), w0 * bfhi(y0.x) + w1 * bfhi(y1.x), w0 * bflo(y0.y) + w1 * bflo(y1.y), w0 * bfhi(y0.y) + w1 * bfhi(y1.y)};
                        v[j] = ((const f32x4*)xr)[lane + 64 * j] + ((const f32x4*)m5)[lane + 64 * j] * f; ((f32x4*)xr)[lane + 64 * j] = v[j]; }
                    const float* mn = MODV + 3 * 6144 + ms * 6144;
                    norm_mod_vals(v, kin(I_GN1) + DM, mn, mn + 1024, HB + (size_t)row * DM, lane);
                }
            }
            const bool split = (G >= 64);
            if (!split || vcu < 32) {
                for (int g = vcu; g < 32; g += (split ? 32 : G))
                    s5_precompute(lc, g, kin(I_LAMRE), kin(I_LAMIM), kin(I_LOGDT), kin(I_BRE), kin(I_BIM), kin(I_CRE), kin(I_CIM), kin(I_S5D), ws, lds);
                if (k == 0) {
                    LAS float* scs = (LAS float*)lds;
                    for (int i = tid; i < 3072; i += 512) { const float cv = (i < 2048) ? kin(I_C)[i] : kin(I_CCTX)[i - 2048]; scs[i] = cv * sigmoidf_(cv); }
                    __syncthreads();
                    const int nwv = split ? 256 : NGW;
                    for (int it = gw; it < 192; it += nwv) modv_item(it, kin(I_WMOD), kin(I_BMOD), MODV, scs, lane);
                    __syncthreads();
                }
            }
            if (!split || vcu >= 32) {
                const int gwc = split ? gw - 256 : gw, ngc = split ? NGW - 256 : NGW;
                conv_layer_weights(kin(I_WIN) + (size_t)lc * 1024 * 4880, kin(I_WGATE) + (size_t)lc * 1024 * 4096, kin(I_WBR) + (size_t)lc * 4 * 512 * 1024, kin(I_WOUT) + (size_t)lc * 1024 * 1024,
                                   kin(I_WGLU) + (size_t)lc * 512 * 512, ws, (LAS float*)(lds + wave * 8448), gwc, ngc, lane);
            }
        } else if constexpr (HAS(1) && k == 1) {
            for (int row = gw; row < RT; row += NGW) { const float* mn = MODV + modsel(row) * 6144; f32x4 v[4];
                norm_mod_row(xrow_ptr(out, xctx, row), kin(I_GN1), mn, mn + 1024, HB + (size_t)row * DM, lane, v); }
        } else if constexpr (HAS(2) && k == 2) {
            pg8::Gemm g{HB, (const bf16_t*)(ws + WS_WG1), 1024, 1024, 1024}; GridOrder S; S.init(NTILE, 36, G, bx, 0);
            EpiG1 E{ws, kin(I_MLBG) + l * 16, kin(I_BGATE) + l * 4096};
            pg8::gemm_phase(lds, g, S, E);
        } else if constexpr (HAS(3) && k == 3) {
            if (SUB(0)) { pg8::Gemm g{(const bf16_t*)(RA + A_UH), (const bf16_t*)(ws + WS_S5BS), 768, 512, 512}; S5Order<1> S{G, vcu}; EpiS5State E{(float*)(RC + C_SST)}; pg8::gemm_phase(lds, g, S, E); }
            if (SUB(1)) { const bf16_t* MLK = (const bf16_t*)(RA + A_P512 + 4 * SZ512), *MLV = (const bf16_t*)(RA + A_P512 + 5 * SZ512);
              for (int it = G - 1 - vcu; it < 1056; it += G) { const int cc = it % MLNC, h = (it / MLNC) & 3, d = (it / (MLNC * 4)) & 1, b = it / (MLNC * 8);
                  ml_stage_a(b, h, cc, d, MLK, MLV, (const float*)(RA + A_MLG), (bf16_t*)(RC + C_CST), (float*)(RC + C_NST), (float*)(RC + C_DEC), lds); } }
            if (SUB(2)) { bf16_t* GQQ = (bf16_t*)(RA + A_P512 + 7 * SZ512); bf16_t* GQK = (bf16_t*)(RA + A_GQK);
              for (int q = gtid; q < RT * 10; q += NTH) gqa_prep_item(q / 10, q % 10, GQQ, GQK, kin(I_GQQN) + l * 64, kin(I_GQKN) + l * 64); }
            __syncthreads();
            if (SUB(3)) na_phase(l, vcu, G, kin(I_RPB) + l * 3720, ws, (char*)lds_raw);
        } else if constexpr (HAS(4) && k == 4) {
            s5_scan((const float*)(RC + C_SST), (const float*)(ws + WS_S5AL), (bf16_t*)(RA + A_UH), gtid, NTH);
            ml_scan((bf16_t*)(RC + C_CST), (float*)(RC + C_NST), (const float*)(RC + C_DEC), gtid, NTH);
            gqa_phase(l, vcu, G, ws, (char*)lds_raw);
        } else if constexpr (HAS(5) && k == 5) {
            pg8::Gemm g{(const bf16_t*)(RA + A_UH), (const bf16_t*)(ws + WS_S5BO), 768, 768, 768}; S5Order<2> S{G, vcu}; EpiS5Out E{(bf16_t*)(RB + B_Z)}; pg8::gemm_phase(lds, g, S, E);
        } else if constexpr (HAS(6) && k == 6) {
            if (SUB(0)) { pg8::Gemm g{(const bf16_t*)(RB + B_Z), (const bf16_t*)(ws + WS_WGLU), 512, 512, 512}; GridOrder S; S.init(last ? 64 : NTILE, 2, G, bx, last ? 1 : 0);
              EpiGlu E{(const bf16_t*)(RB + B_Z), (bf16_t*)RB, kin(I_BGLU) + l * 512}; pg8::gemm_phase(lds, g, S, E); }
            if (SUB(1)) { const bf16_t* P = (const bf16_t*)(RA + A_P512); const int ncc = last ? 64 : 66, nit = NB * 4 * ncc;
              for (int it = G - 1 - vcu; it < nit; it += G) { const int cc = it % ncc + (last ? 2 : 0), h = (it / ncc) & 3, b = it / (ncc * 4);
                  ml_stage_c(b, h, cc, P + 3 * (size_t)RT * 512, P + 4 * (size_t)RT * 512, P + 5 * (size_t)RT * 512, P + 6 * (size_t)RT * 512, (const float*)(RA + A_MLG), (const bf16_t*)(RC + C_CST), (const float*)(RC + C_NST),
                             kin(I_MLNORM) + l * 512, (bf16_t*)(RB + 2 * SZ512), lds); } }
        } else if constexpr (HAS(7) && k == 7) {
            pg8::Gemm g{(const bf16_t*)RB, (const bf16_t*)(ws + WS_WBR), 512, 512, 512}; QuadOrder S; S.init(last ? 64 : NTILE, 4, G, bx, last ? 1 : 0);
            EpiMerge E{(const bf16_t*)(RA + A_GATE), (float*)(RA + A_MSUM), HB}; pg8::gemm_phase(lds, g, S, E);
        } else if constexpr (HAS(8) && k == 8) {
            { pg8::Gemm g{HB, (const bf16_t*)(ws + WS_WOUT), 1024, 1024, 1024}; GridOrder S; S.init(last ? 64 : NTILE, 4, G, bx, last ? 1 : 0);
              EpiWout E{out, xctx, modl}; pg8::gemm_phase(lds, g, S, E); }
            conv_moe_weights(kin(I_W1) + (size_t)l * 32 * 1024 * 512, kin(I_W3) + (size_t)l * 32 * 1024 * 512, kin(I_W2) + (size_t)l * 32 * 512 * 1024, ws, (LAS float*)(lds + wave * 8448), gw, NGW, lane);
        } else if constexpr (HAS(9) && k == 9) {
            LAS float* wl = (LAS float*)lds;
            for (int i = tid; i < 1024 * 32; i += 512) { const int kk = i >> 5, e = i & 31; wl[((kk & 3) * 256 + (kk >> 2)) * 36 + e] = kin(I_WROUTER)[i]; }
            __syncthreads();
            unsigned* cnt = ctl + CW_CNT + 64 * l;
            for (int row = gw; row < RT; row += NGW) {
                const int ms = modsel(row); if (last && ms == 2) continue;
                const float* mn = modl + ms * 6144; f32x4 v[4];
                norm_mod_row(xrow_ptr(out, xctx, row), kin(I_GN2) + l * DM, mn + 3 * 1024, mn + 4 * 1024, HB + (size_t)row * DM, lane, v);
                float lg[32];
#pragma unroll
                for (int i = 0; i < 32; ++i) lg[i] = 0.f;
#pragma unroll
                for (int j = 0; j < 4; ++j)
#pragma unroll
                    for (int e = 0; e < 4; ++e) { const float hv = v[j][e]; const LAS f32x4* wp = (const LAS f32x4*)(wl + (e * 256 + lane + 64 * j) * 36);
#pragma unroll
                        for (int q = 0; q < 8; ++q) { const f32x4 w = wp[q]; lg[4 * q] += hv * w.x; lg[4 * q + 1] += hv * w.y; lg[4 * q + 2] += hv * w.z; lg[4 * q + 3] += hv * w.w; } }
#pragma unroll
                for (int i = 0; i < 32; ++i) lg[i] = wave_sum(lg[i]);
                int e0, e1; float w0, w1; route_token(lg, kin(I_BROUTER), e0, e1, w0, w1);
                if (lane == 0) { const int p0 = (int)atomicAdd(cnt + e0, 1u), p1 = (int)atomicAdd(cnt + e1, 1u);
                    TOK_E[row * 2] = e0; TOK_E[row * 2 + 1] = e1; TOK_W[row * 2] = w0; TOK_W[row * 2 + 1] = w1; TOK_DST[row * 2] = p0; TOK_DST[row * 2 + 1] = p1; }
            }
            __syncthreads();
        } else if constexpr (HAS(10) && k == 10) {
            (void)moe_offsets(ctl + CW_CNT + 64 * l, offs, texp);
            bf16_t* MBUF = (bf16_t*)(RA + A_MBUF);
            for (int row = gw; row < RT; row += NGW) {
                if (last && modsel(row) == 2) continue;
                const int d0 = offs[TOK_E[row * 2]] + TOK_DST[row * 2], d1 = offs[TOK_E[row * 2 + 1]] + TOK_DST[row * 2 + 1];
                const u32x4 v0 = ((const u32x4*)(HB + (size_t)row * DM))[lane], v1 = ((const u32x4*)(HB + (size_t)row * DM))[lane + 64];
                ((u32x4*)(MBUF + (size_t)d0 * DM))[lane] = v0; ((u32x4*)(MBUF + (size_t)d0 * DM))[lane + 64] = v1;
                ((u32x4*)(MBUF + (size_t)d1 * DM))[lane] = v0; ((u32x4*)(MBUF + (size_t)d1 * DM))[lane + 64] = v1;
                if (lane == 0) { TOK_DST[row * 2] = d0; TOK_DST[row * 2 + 1] = d1; }
            }
            __syncthreads();
        } else if constexpr (HAS(11) && k == 11) {
            const int nt = moe_offsets(ctl + CW_CNT + 64 * l, offs, texp);
            pg8::Gemm g{(const bf16_t*)(RA + A_MBUF), (const bf16_t*)(RA + A_W13), 1024, 1024, 1024}; MoeOrder S{G, vcu, nt, texp}; EpiMoe1 E{(bf16_t*)(RA + A_MH)}; pg8::gemm_phase(lds, g, S, E);
        } else if constexpr (HAS(12) && k == 12) {
            const int nt = moe_offsets(ctl + CW_CNT + 64 * l, offs, texp);
            pg8::Gemm g{(const bf16_t*)(RA + A_MH), (const bf16_t*)(RA + A_W2), 512, 512, 512}; MoeOrder S{G, vcu, nt, texp}; EpiMoe2 E{(bf16_t*)(RA + A_MY)}; pg8::gemm_phase(lds, g, S, E);
        } else if constexpr (HAS(13) && k == 13) {
            const bf16_t* MY = (const bf16_t*)(RA + A_MY);
            for (int row = gw; row < RT; row += NGW) {
                const int ms = modsel(row); if (ms == 2) continue;
                float* xr = xrow_ptr(out, xctx, row); const float* m5 = modl + ms * 6144 + 5 * 1024;
                const int d0 = TOK_DST[row * 2], d1 = TOK_DST[row * 2 + 1]; const float w0 = TOK_W[row * 2], w1 = TOK_W[row * 2 + 1];
                f32x4 v[4]; float s = 0.f;
#pragma unroll
                for (int j = 0; j < 4; ++j) { const u32x2 y0 = ((const u32x2*)(MY + (size_t)d0 * 1024))[lane + 64 * j], y1 = ((const u32x2*)(MY + (size_t)d1 * 1024))[lane + 64 * j];
                    const f32x4 f = (f32x4){w0 * bflo(y0.x) + w1 * bflo(y1.x), w0 * bfhi(y0.x) + w1 * bfhi(y1.x), w0 * bflo(y0.y) + w1 * bflo(y1.y), w0 * bfhi(y0.y) + w1 * bfhi(y1.y)};
                    v[j] = ((const f32x4*)xr)[lane + 64 * j] + ((const f32x4*)m5)[lane + 64 * j] * f; s += (v[j].x * v[j].x + v[j].y * v[j].y) + (v[j].z * v[j].z + v[j].w * v[j].w); }
                const float rstd = rsqrtf(wave_sum(s) * (1.f / DM) + 1e-6f);
#pragma unroll
                for (int j = 0; j < 4; ++j) ((f32x4*)xr)[lane + 64 * j] = v[j] * rstd * ((const f32x4*)kin(I_GFINAL))[lane + 64 * j];
            }
        }
    }
}

__global__ void __launch_bounds__(512, 2) hybrid_fwd(Args a) {
    LAS unsigned char* lds = (LAS unsigned char*)lds_raw;
    { const int t0 = threadIdx.x; if ((t0 & 63) == 0) ((volatile LAS int*)(lds + WMAP_OFF))[(unsigned)__builtin_amdgcn_s_getreg((5 << 11) | 4) & 63u] = t0 >> 6; }
    __syncthreads();
    const int tid0 = otid();
    const int G = gridDim.x, bx = blockIdx.x, vcu = (G % 8 == 0) ? (bx % 8) * (G / 8) + bx / 8 : bx;
    volatile LAS unsigned* MISC = (volatile LAS unsigned*)(lds + MISC_OFF);
    if (tid0 < 16) MISC[tid0] = 0u;
    __syncthreads();
    const int lo = a.ph_lo, hi = a.ph_hi;
    XcdBarrier bar; bar.bar = (unsigned*)(a.ws + WS_CTL) + CW_BAR; bar.x = 0; bar.st = MISC;
    if (hi - lo > 1) bar = xcd_barrier_post((unsigned*)(a.ws + WS_CTL) + CW_BAR, MISC);
#define SEAM(ph) do { if ((ph) + 1 < hi) { if constexpr ((ph) == 0) { __threadfence(); cg::this_grid().sync(); __builtin_amdgcn_fence(__ATOMIC_ACQUIRE, "agent"); asm volatile("s_waitcnt vmcnt(0)" ::: "memory"); __syncthreads(); } else xcd_barrier(bar); } } while (0)
#define PH(ph, K, L) do { if (lo <= (ph) && (ph) < hi) { run_phase<K, L>(a.ws, a.out, vcu, G, bx, lds, lds_raw); SEAM(ph); } } while (0)
    PH(0, 0, 0); PH(1, 1, 0);
    PH(2, 2, 0); PH(3, 3, 0); PH(4, 4, 0); PH(5, 5, 0); PH(6, 6, 0); PH(7, 7, 0); PH(8, 8, 0); PH(9, 9, 0); PH(10, 10, 0); PH(11, 11, 0); PH(12, 12, 0); PH(13, 13, 0);
    PH(14, 2, 1); PH(15, 3, 1); PH(16, 4, 1); PH(17, 5, 1); PH(18, 6, 1); PH(19, 7, 1); PH(20, 8, 1); PH(21, 9, 1); PH(22, 10, 1); PH(23, 11, 1); PH(24, 12, 1); PH(25, 13, 1);
#undef PH
#undef SEAM
}

extern "C" void kernel_launch(void* const* d_in, const int* in_sizes, int n_in, void* d_out, int out_size, void* d_ws, size_t ws_size, hipStream_t stream) {
    static int grid = 0;
    if (grid == 0) {
        if (n_in != 34 || out_size != NB * SEQ * DM || ws_size < WS_END) { fprintf(stderr, "kernel_launch: unexpected problem (n_in %d out %d ws %zu, need ws >= %zu)\n", n_in, out_size, ws_size, (size_t)WS_END); grid = -1; return; }
        int dev = 0, cus = 0, per_cu = 0;
        hipGetDevice(&dev); hipDeviceGetAttribute(&cus, hipDeviceAttributeMultiprocessorCount, dev);
        if (hipFuncSetAttribute((const void*)hybrid_fwd, hipFuncAttributeMaxDynamicSharedMemorySize, LDS_BYTES) != hipSuccess) { fprintf(stderr, "kernel_launch: hipFuncSetAttribute failed\n"); grid = -1; return; }
        if (hipOccupancyMaxActiveBlocksPerMultiprocessor(&per_cu, (const void*)hybrid_fwd, 512, LDS_BYTES) != hipSuccess || per_cu < 1) { fprintf(stderr, "kernel_launch: occupancy query says %d blocks per CU\n", per_cu); grid = -1; return; }
        (void)hipGetLastError();
        grid = cus;
    }
    if (grid < 0) return;
    hipMemsetAsync((char*)d_ws + WS_CTL, 0, CTL_BYTES, stream);
    Args a{};
    for (int i = 0; i < 34; ++i) a.in[i] = (const float*)d_in[i];
    a.out = (float*)d_out; a.ws = (unsigned char*)d_ws;
#if MK_MULTI
    for (int ph = 0; ph < NPHASE; ++ph) { a.ph_lo = ph; a.ph_hi = ph + 1; void* args[] = {&a};
        hipError_t e = hipLaunchCooperativeKernel((const void*)hybrid_fwd, dim3(grid), dim3(512), args, LDS_BYTES, stream);
        if (e != hipSuccess) { fprintf(stderr, "launch %d failed: %s\n", ph, hipGetErrorString(e)); break; } }
#else
    a.ph_lo = 0; a.ph_hi = NPHASE; void* args[] = {&a};
    hipError_t e = hipLaunchCooperativeKernel((const void*)hybrid_fwd, dim3(grid), dim3(512), args, LDS_BYTES, stream);
    if (e != hipSuccess) fprintf(stderr, "cooperative launch failed: %s (grid %d)\n", hipGetErrorString(e), grid);
#endif
}
```

```cpp
#include <hip/hip_runtime.h>
#include <hip/hip_bf16.h>
#include <hip/hip_cooperative_groups.h>
#include <cstdio>
#include <cstdint>
#include <cmath>
namespace cg = cooperative_groups;

#define LAS __attribute__((address_space(3)))
#define GAS __attribute__((address_space(1)))
typedef unsigned short bf16_t;
typedef short bf16x8 __attribute__((ext_vector_type(8)));
typedef short s16x4 __attribute__((ext_vector_type(4)));
typedef float f32x2 __attribute__((ext_vector_type(2)));
typedef float f32x4 __attribute__((ext_vector_type(4)));
typedef float f32x16 __attribute__((ext_vector_type(16)));
typedef unsigned u32x2 __attribute__((ext_vector_type(2)));
typedef unsigned u32x4 __attribute__((ext_vector_type(4)));

constexpr int DM = 1024, NB = 2, SEQ = 8192, CTX = 256, SB = SEQ + CTX  , RT = NB * SB  ;
constexpr int BW = 512, NTILE = RT / 256  , TPB = SB / 256  ;
constexpr int NMOD = 6;
constexpr int S5L = 32  , S5NC = SB / S5L  , S5ROWS = NB * S5NC  , S5RP = 768  ;
constexpr int MLC = 128, MLNC = SB / MLC  ;
constexpr int NEXP = 32, MOE_MAXROWS = RT * 2 + NEXP * 256  , MOE_MAXT = MOE_MAXROWS / 256  ;
constexpr float LOG2E = 1.4426950408889634f;

extern __shared__ __attribute__((aligned(16))) unsigned char lds_raw[];
constexpr int LDS_BYTES = 155648, MISC_OFF = 151552, WMAP_OFF = MISC_OFF + 1024;
__device__ __forceinline__ int otid() {
    const unsigned hw = (unsigned)__builtin_amdgcn_s_getreg((5 << 11) | 4) & 63u;
    const int w = ((const volatile LAS int*)((LAS unsigned char*)lds_raw + WMAP_OFF))[hw];
    int t = w * 64 + (int)__builtin_amdgcn_mbcnt_hi(~0u, __builtin_amdgcn_mbcnt_lo(~0u, 0u)); asm volatile("" : "+v"(t)); return t; }
__device__ __forceinline__ unsigned f2bf(float f) { unsigned u = __builtin_bit_cast(unsigned, f); return (u + 0x7fffu + ((u >> 16) & 1u)) >> 16; }
__device__ __forceinline__ unsigned pk2(float lo, float hi) { return f2bf(lo) | (f2bf(hi) << 16); }
__device__ __forceinline__ float bf2f(unsigned short b) { return __builtin_bit_cast(float, ((unsigned)b) << 16); }
__device__ __forceinline__ float bflo(unsigned w) { return __builtin_bit_cast(float, w << 16); }
__device__ __forceinline__ float bfhi(unsigned w) { return __builtin_bit_cast(float, w & 0xffff0000u); }
__device__ __forceinline__ float wave_sum(float v) {
#pragma unroll
    for (int o = 1; o < 64; o <<= 1) v += __shfl_xor(v, o);
    return v;
}
__device__ __forceinline__ float sigmoidf_(float x) { return 1.f / (1.f + __expf(-x)); }
__device__ __forceinline__ float log_sigmoidf_(float x) { return fminf(x, 0.f) - log1pf(__expf(-fabsf(x))); }
__device__ __forceinline__ float gelu_tanh(float x) { const float u = 0.7978845608028654f * (x + 0.044715f * x * x * x); return x * sigmoidf_(2.f * u); }

namespace pg8 {
constexpr int BM = 256, BK = 64, HALF = 128, HTB = HALF * BK * 2, STAGE_BYTES = 8 * HTB;
__host__ __device__ __forceinline__ int lds_byte(int r, int c) { const int st = (r >> 4) * 2 + (c >> 5), rr = r & 15, cc = c & 31, ob = rr * 64 + cc * 2; return st * 1024 + (ob ^ (((ob >> 9) & 1) << 5)); }
__host__ __device__ __forceinline__ void stage_rc(int b, int& R, int& C) { const int st = b / 1024, sb = b % 1024, swz = sb ^ (((sb >> 9) & 1) << 5); R = (st >> 1) * 16 + swz / 64; C = (st & 1) * 32 + (swz % 64) / 2; }
__host__ __device__ __forceinline__ int perm32(int rho) { const int n = rho >> 4, i = rho & 15; return 8 * (i >> 2) + 4 * n + (i & 3); }
struct Unit { int pm, pn, z, pad; long aoff, boff; };
struct Gemm { const bf16_t* A; const bf16_t* Bt; int lda, ldb, K; };
__device__ __forceinline__ unsigned cvt_pk_bf16(float lo, float hi) { unsigned r; asm volatile("v_cvt_pk_bf16_f32 %0, %1, %2" : "=v"(r) : "v"(lo), "v"(hi)); return r; }

template <class Epi, class Sched>
__device__ __forceinline__ void gemm_phase(LAS unsigned char* lds, const Gemm g, const Sched& S, const Epi& E) {
    const int tid = otid(), wid = __builtin_amdgcn_readfirstlane(tid >> 6), lane = tid & 63, wr = wid >> 2, wc = wid & 3, fr = lane & 15, fq = lane >> 4;
    const int K = g.K, nt = K / BK;
    unsigned voffA[2], voffB[2];
#pragma unroll
    for (int i = 0; i < 2; ++i) { int R, C; stage_rc(tid * 16 + i * 8192, R, C); const int Rb = (R & ~31) + perm32(R & 31);
        voffA[i] = (unsigned)(R * g.lda + C) * 2u; voffB[i] = (unsigned)(Rb * g.ldb + C) * 2u; }
    const size_t kstep = (size_t)(BK * 2);
    const size_t hstepA = (size_t)HALF * g.lda * 2, hstepB = (size_t)HALF * g.ldb * 2;
    const size_t tstepA = 2 * hstepA, tstepB = 2 * hstepB;
    const unsigned ldsw = (unsigned)wid * 1024u;
    const int aoff = lds_byte(wr * 64 + fr, fq * 8), boff = lds_byte(wc * 32 + fr, fq * 8);
#define PG8_SA(b, h) (((b) * 2 + (h)) * HTB)
#define PG8_SB(b, h) ((4 + (b) * 2 + (h)) * HTB)
#define PG8_STAGE(bufoff, gbase, voff) do { _Pragma("unroll") for (int _i = 0; _i < 2; ++_i) \
        __builtin_amdgcn_global_load_lds((const unsigned*)((const char*)(gbase) + (voff)[_i]), (LAS unsigned*)(lds + (bufoff) + ldsw + _i * 8192), 16, 0, 0); } while (0)
#define PG8_LDA(dst, b, h) do { _Pragma("unroll") for (int m = 0; m < 4; ++m) _Pragma("unroll") for (int k = 0; k < 2; ++k) dst[m][k] = *(const LAS bf16x8*)(lds + PG8_SA(b, h) + aoff + m * 2048 + k * 1024); } while (0)
#define PG8_LDB(dst, b, h) do { _Pragma("unroll") for (int n = 0; n < 2; ++n) _Pragma("unroll") for (int k = 0; k < 2; ++k) dst[n][k] = *(const LAS bf16x8*)(lds + PG8_SB(b, h) + boff + n * 2048 + k * 1024); } while (0)
#define PG8_MMA(ai, bj, At, Bt) do { __builtin_amdgcn_s_setprio(1); _Pragma("unroll") for (int m = 0; m < 4; ++m) _Pragma("unroll") for (int n = 0; n < 2; ++n) _Pragma("unroll") for (int k = 0; k < 2; ++k) \
        acc[ai][bj][m][n] = __builtin_amdgcn_mfma_f32_16x16x32_bf16(Bt[n][k], At[m][k], acc[ai][bj][m][n], 0, 0, 0); __builtin_amdgcn_s_setprio(0); } while (0)
#define PG8_WAIT_V(n) asm volatile("s_waitcnt vmcnt(" #n ")" ::: "memory")
#define PG8_WAIT_L(n) asm volatile("s_waitcnt lgkmcnt(" #n ")" ::: "memory")
#define PG8_BAR __builtin_amdgcn_s_barrier()
#define PG8_SCHED __builtin_amdgcn_sched_barrier(0)
    Unit cur, nxt; int ui = 0;
    if (!S.next(0, cur)) return;
#define PG8_UNI(u) do { (u).pm = __builtin_amdgcn_readfirstlane((u).pm); (u).pn = __builtin_amdgcn_readfirstlane((u).pn); (u).z = __builtin_amdgcn_readfirstlane((u).z); } while (0)
    PG8_UNI(cur);
    f32x4 acc[2][2][4][2];
#pragma unroll
    for (int a = 0; a < 2; ++a)
#pragma unroll
        for (int b = 0; b < 2; ++b)
#pragma unroll
            for (int m = 0; m < 4; ++m)
#pragma unroll
                for (int n = 0; n < 2; ++n) acc[a][b][m][n] = (f32x4){0.f, 0.f, 0.f, 0.f};
    bf16x8 At[4][2], B0[2][2], B1[2][2];
    const char* cA = (const char*)g.A + (size_t)cur.pm * tstepA + cur.aoff; const char* cB = (const char*)g.Bt + (size_t)cur.pn * tstepB + cur.boff;
    PG8_STAGE(PG8_SB(0, 0), cB, voffB); PG8_STAGE(PG8_SB(0, 1), cB + hstepB, voffB); PG8_STAGE(PG8_SA(0, 0), cA, voffA); PG8_STAGE(PG8_SA(0, 1), cA + hstepA, voffA);
    if (wr == 1) PG8_BAR;
    PG8_WAIT_V(2); PG8_BAR;
    PG8_STAGE(PG8_SB(1, 0), cB + kstep, voffB); PG8_STAGE(PG8_SA(1, 0), cA + kstep, voffA); PG8_STAGE(PG8_SB(1, 1), cB + hstepB + kstep, voffB);
    PG8_WAIT_V(6); PG8_BAR;
    for (;;) {
        const bool has_next = S.next(ui + 1, nxt); PG8_UNI(nxt);
        const char* nA = has_next ? (const char*)g.A + (size_t)nxt.pm * tstepA + nxt.aoff : cA; const char* nB = has_next ? (const char*)g.Bt + (size_t)nxt.pn * tstepB + nxt.boff : cB;
        for (int t = 0; t < nt; t += 2) {
            const bool last = (t == nt - 2);
            const char* a1 = cA + (size_t)(t + 1) * kstep;
            const char* a2 = last ? nA : cA + (size_t)(t + 2) * kstep; const char* b2 = last ? nB : cB + (size_t)(t + 2) * kstep;
            const char* a3 = a2 + kstep; const char* b3 = b2 + kstep;
            PG8_LDB(B0, 0, 0); PG8_LDB(B1, 0, 1); PG8_SCHED; PG8_LDA(At, 0, 0); PG8_STAGE(PG8_SA(1, 1), a1 + hstepA, voffA);
            PG8_WAIT_V(8); PG8_WAIT_L(0); PG8_BAR; PG8_MMA(0, 0, At, B0); PG8_MMA(0, 1, At, B1); PG8_BAR; PG8_SCHED;
            PG8_LDA(At, 0, 1); PG8_STAGE(PG8_SB(0, 0), b2, voffB); PG8_STAGE(PG8_SB(0, 1), b2 + hstepB, voffB); PG8_STAGE(PG8_SA(0, 0), a2, voffA);
            PG8_WAIT_V(8); PG8_WAIT_L(0); PG8_BAR; PG8_MMA(1, 0, At, B0); PG8_MMA(1, 1, At, B1); PG8_BAR; PG8_SCHED;
            PG8_LDB(B0, 1, 0); PG8_LDB(B1, 1, 1); PG8_SCHED; PG8_LDA(At, 1, 0); PG8_STAGE(PG8_SA(0, 1), a2 + hstepA, voffA);
            PG8_WAIT_V(8); PG8_WAIT_L(0); PG8_BAR; PG8_MMA(0, 0, At, B0); PG8_MMA(0, 1, At, B1); PG8_BAR; PG8_SCHED;
            PG8_LDA(At, 1, 1); PG8_STAGE(PG8_SB(1, 0), b3, voffB); PG8_STAGE(PG8_SB(1, 1), b3 + hstepB, voffB); PG8_STAGE(PG8_SA(1, 0), a3, voffA);
            PG8_WAIT_V(8); PG8_WAIT_L(0); PG8_BAR; PG8_MMA(1, 0, At, B0); PG8_MMA(1, 1, At, B1); PG8_BAR; PG8_SCHED;
        }
        if (wr == 0) PG8_BAR;
        E(acc, cur, wr, wc, fr, fq);
        if (!has_next) break;
#pragma unroll
        for (int a = 0; a < 2; ++a)
#pragma unroll
            for (int b = 0; b < 2; ++b)
#pragma unroll
                for (int m = 0; m < 4; ++m)
#pragma unroll
                    for (int n = 0; n < 2; ++n) acc[a][b][m][n] = (f32x4){0.f, 0.f, 0.f, 0.f};
        cur = nxt; cA = nA; cB = nB; ++ui;
        if (wr == 1) PG8_BAR;
    }
    PG8_WAIT_V(0);
    PG8_BAR;
#undef PG8_SA
#undef PG8_SB
#undef PG8_STAGE
#undef PG8_LDA
#undef PG8_LDB
#undef PG8_MMA
#undef PG8_WAIT_V
#undef PG8_WAIT_L
#undef PG8_BAR
#undef PG8_SCHED
#undef PG8_UNI
}
}
namespace attn_body {
using bf16 = __hip_bfloat16;
constexpr int D = 64, NW = 8, QBLK = 32, QB = QBLK * NW, KVBLK = 64;
__device__ __forceinline__ int crow(int r, int hi) { return (r & 3) + 8 * (r >> 2) + 4 * hi; }
#define SBAR() __builtin_amdgcn_sched_barrier(0)
constexpr int NSLOT = 3, SLOTB = 8192;
constexpr int LDS_K = 0, LDS_V = NSLOT * SLOTB, LDS_WS = 2 * NSLOT * SLOTB, LDS_OST = LDS_WS + NW * 64 * 4, LDS_BYTES = LDS_OST + NW * 4096;
__device__ __forceinline__ void glds16(const void* gsrc, unsigned lds_dst) { unsigned keep;
  asm volatile("s_mov_b32 %0, m0\n\ts_mov_b32 m0, %2\n\ts_nop 0\n\tglobal_load_lds_dwordx4 %1, off\n\ts_mov_b32 m0, %0" : "=&s"(keep) : "v"(gsrc), "s"(lds_dst) : "memory"); }
__device__ __forceinline__ float max3f(float a, float b, float c) { float r; asm("v_max3_f32 %0, %1, %2, %3" : "=v"(r) : "v"(a), "v"(b), "v"(c)); return r; }
__device__ __forceinline__ float max2f(float a, float b) { float r; asm("v_max_f32_e32 %0, %1, %2" : "=v"(r) : "v"(a), "v"(b)); return r; }
__device__ __forceinline__ float fadd_s(float a, float b) { float r; asm("v_add_f32_e32 %0, %1, %2" : "=v"(r) : "v"(a), "v"(b)); return r; }
__device__ __forceinline__ float fsub_s(float a, float b) { float r; asm("v_sub_f32_e32 %0, %1, %2" : "=v"(r) : "v"(a), "v"(b)); return r; }
typedef float f32x2_t __attribute__((ext_vector_type(2))); typedef __bf16 bf16x2_t __attribute__((ext_vector_type(2)));
__device__ __forceinline__ unsigned cvtpk_s(float lo, float hi) { f32x2_t v = {lo, hi}; bf16x2_t b = __builtin_convertvector(v, bf16x2_t); return __builtin_bit_cast(unsigned, b); }
#define WAIT_BAR(N) asm volatile("s_waitcnt vmcnt(" #N ") lgkmcnt(0)\n\ts_barrier" ::: "memory")
__device__ __forceinline__ void qkt(f32x16& p0, f32x16& p1, const char* Kslot, const bf16x8* qr, const f32x16& negm, int r32, int hi) {
  const char* kb = Kslot + hi * 1024 + r32 * 16;
#pragma unroll
  for (int d0 = 0; d0 < 4; ++d0) {
    const bf16x8 b0 = *reinterpret_cast<const bf16x8*>(kb + d0 * 2048);
    const bf16x8 b1 = *reinterpret_cast<const bf16x8*>(kb + d0 * 2048 + 512);
    if (d0 == 0) { p0 = __builtin_amdgcn_mfma_f32_32x32x16_bf16(b0, qr[0], negm, 0, 0, 0); p1 = __builtin_amdgcn_mfma_f32_32x32x16_bf16(b1, qr[0], negm, 0, 0, 0); }
    else { p0 = __builtin_amdgcn_mfma_f32_32x32x16_bf16(b0, qr[d0], p0, 0, 0, 0); p1 = __builtin_amdgcn_mfma_f32_32x32x16_bf16(b1, qr[d0], p1, 0, 0, 0); } }
}
typedef __attribute__((address_space(3))) const char* lds_cptr;
typedef short v4i16_t __attribute__((ext_vector_type(4)));
__device__ __forceinline__ void kload8(bf16x8* kf, lds_cptr kp) {
  kf[0] = *(const LAS bf16x8*)(kp);        kf[1] = *(const LAS bf16x8*)(kp + 512);
  kf[2] = *(const LAS bf16x8*)(kp + 2048); kf[3] = *(const LAS bf16x8*)(kp + 2560);
  kf[4] = *(const LAS bf16x8*)(kp + 4096); kf[5] = *(const LAS bf16x8*)(kp + 4608);
  kf[6] = *(const LAS bf16x8*)(kp + 6144); kf[7] = *(const LAS bf16x8*)(kp + 6656);
}
__device__ __forceinline__ void kload2(bf16x8* kf, lds_cptr kp, int j) { kf[2 * j] = *(const LAS bf16x8*)(kp + j * 2048); kf[2 * j + 1] = *(const LAS bf16x8*)(kp + j * 2048 + 512); }
__device__ __forceinline__ s16x4 vtr(lds_cptr p) { return __builtin_bit_cast(s16x4, __builtin_amdgcn_ds_read_tr16_b64_v4i16((LAS v4i16_t*)p)); }
__device__ __forceinline__ float rowmax(const f32x16& p0, const f32x16& p1) {
  float a = max3f(p0[0], p0[1], p1[0]), b = max3f(p0[2], p0[3], p1[1]); a = max3f(a, p1[2], p1[3]);
#pragma unroll
  for (int r = 4; r < 16; r += 4) { a = max3f(a, p0[r], p0[r + 1]); b = max3f(b, p0[r + 2], p0[r + 3]); a = max3f(a, p1[r], p1[r + 1]); b = max3f(b, p1[r + 2], p1[r + 3]); }
  const float m = max2f(a, b);
  auto rr = __builtin_amdgcn_permlane32_swap(__float_as_uint(m), __float_as_uint(m), false, false);
  return max2f(__uint_as_float(rr[0]), __uint_as_float(rr[1]));
}
__device__ __forceinline__ void pv(f32x16* o, int vb, bf16x8 pa0, bf16x8 pa1, bf16x8 pa2, bf16x8 pa3) {
#pragma unroll
  for (int d0 = 0; d0 < 2; ++d0) { s16x4 lo[4], hi[4];
#pragma unroll
    for (int ks = 0; ks < 4; ++ks) {
      asm volatile("ds_read_b64_tr_b16 %0,%1 offset:%c2" : "=&v"(lo[ks]) : "v"(vb), "i"(d0 * 4096 + ks * 1024) : "memory");
      asm volatile("ds_read_b64_tr_b16 %0,%1 offset:%c2" : "=&v"(hi[ks]) : "v"(vb), "i"(d0 * 4096 + ks * 1024 + 512) : "memory"); }
    asm volatile("s_waitcnt lgkmcnt(0)" ::: "memory"); SBAR();
#define PK(k) (bf16x8){lo[k][0], lo[k][1], lo[k][2], lo[k][3], hi[k][0], hi[k][1], hi[k][2], hi[k][3]}
    o[d0] = __builtin_amdgcn_mfma_f32_32x32x16_bf16(pa0, PK(0), o[d0], 0, 0, 0);
    o[d0] = __builtin_amdgcn_mfma_f32_32x32x16_bf16(pa1, PK(1), o[d0], 0, 0, 0);
    o[d0] = __builtin_amdgcn_mfma_f32_32x32x16_bf16(pa2, PK(2), o[d0], 0, 0, 0);
    o[d0] = __builtin_amdgcn_mfma_f32_32x32x16_bf16(pa3, PK(3), o[d0], 0, 0, 0);
#undef PK
  }
}
struct NoHook { static constexpr bool ON = false; __device__ __forceinline__ void operator()(f32x16&, f32x16&, int, int, int, int, float) const {} };

template <int THRL, class RS, class Hook>
__device__ __forceinline__ void attn_unit(const bf16* Qw0, int QP, const bf16* __restrict__ Kb, const bf16* __restrict__ Vb, int KP, const RS rs, const int NT, bf16* Ow0, int OP, char* shm, const Hook hook) {
  const int tid = otid(), lane = tid & 63, r32 = lane & 31, hi = lane >> 5; const int wid = __builtin_amdgcn_readfirstlane(tid >> 6);
  const bf16* Qw = Qw0 + (long)(wid * QBLK) * QP;
  const unsigned lds0 = (unsigned)(uintptr_t)shm;
  float* wsf = (float*)(shm + LDS_WS) + wid * 64;
  const bf16* ksrc = Kb + (long)lane * KP + wid * 8;
  const bf16* vsrc = Vb + (long)(16 * (wid & 3) + (lane >> 2)) * KP + (wid >> 2) * 32 + (lane & 3) * 8;
  const unsigned kdst = lds0 + LDS_K + wid * 1024, vdst = lds0 + LDS_V + wid * 1024;
#define DMA_K(t, slot) glds16(ksrc + (long)rs(t) * KP, (unsigned)__builtin_amdgcn_readfirstlane(kdst + (slot)))
#define DMA_V(t, slot) glds16(vsrc + (long)rs(t) * KP, (unsigned)__builtin_amdgcn_readfirstlane(vdst + (slot)))
  const int vb0 = (int)(lds0 + LDS_V) + ((lane >> 4) & 1) * 32 + (lane & 3) * 8 + (4 * hi + ((lane & 15) >> 2)) * 64;
  const char* Kbase = shm + LDS_K; bf16x8 kf[8];
  const lds_cptr shm3 = (lds_cptr)shm; const lds_cptr kp0 = shm3 + LDS_K + hi * 1024 + r32 * 16; const lds_cptr vp0 = shm3 + LDS_V + ((lane >> 4) & 1) * 32 + (lane & 3) * 8 + (4 * hi + ((lane & 15) >> 2)) * 64;
  DMA_K(0, 0); DMA_V(0, 0); DMA_K(1, SLOTB);
  bf16x8 qr[4];
#pragma unroll
  for (int d0 = 0; d0 < 4; ++d0) qr[d0] = *reinterpret_cast<const bf16x8*>(&Qw[(long)r32 * QP + d0 * 16 + hi * 8]);
  constexpr bool NONEGM = Hook::ON;
  float mhat = 0.f, l_reg = 0.f; f32x16 o[2]; o[0] = f32x16{}; o[1] = f32x16{}; f32x16 negm = f32x16{}; if constexpr (!NONEGM) asm volatile("" : "+v"(negm));
#define CMASK(P0, P1, t) do { if constexpr (Hook::ON) hook(P0, P1, (t), wid, r32, hi, mhat); } while (0)
  bool resc = false;
#define START(P0, P1) do { const float rm = rowmax(P0, P1); resc = false; \
    { const float dl = rm; mhat = fadd_s(mhat, dl); \
      _Pragma("unroll") for (int r = 0; r < 16; ++r) { P0[r] = fsub_s(P0[r], dl); P1[r] = fsub_s(P1[r], dl); } \
      if constexpr (!NONEGM) { _Pragma("unroll") for (int r = 0; r < 16; ++r) negm[r] = -mhat; asm volatile("" : "+v"(negm)); } } \
    _Pragma("unroll") for (int r = 0; r < 16; ++r) P0[r] = __builtin_amdgcn_exp2f(P0[r]); } while (0)
#define RESC() do { if (resc) { asm volatile("s_waitcnt lgkmcnt(0)" ::: "memory"); \
      _Pragma("unroll") for (int d_ = 0; d_ < 2; ++d_) _Pragma("unroll") for (int r = 0; r < 16; ++r) o[d_][r] *= wsf[crow(r, hi)]; } } while (0)
  f32x16 pA0, pA1, pB0, pB1;
  int sl_prev = 0, sl_cur = 0, sl_next = SLOTB;
#define ROT() do { sl_prev = sl_cur; sl_cur = sl_next; sl_next = (sl_next == (NSLOT - 1) * SLOTB) ? 0 : sl_next + SLOTB; } while (0)
  DMA_K(2, 2 * SLOTB);
  WAIT_BAR(3);
  qkt(pA0, pA1, Kbase, qr, negm, r32, hi); asm volatile("s_nop 15\n\ts_nop 7" : "+v"(pA0), "+v"(pA1)); CMASK(pA0, pA1, 0);
  START(pA0, pA1);
  _Pragma("unroll") for (int r = 0; r < 16; ++r) pA1[r] = __builtin_amdgcn_exp2f(pA1[r]);
  WAIT_BAR(0);
  DMA_K(3, 0); DMA_V(1, SLOTB);
  ROT();
  kload8(kf, kp0 + sl_cur);
  WAIT_BAR(2);
  s16x4 vlo[8], vhi[8]; u32x4 pw0, pw1, pw2, pw3;
#define PKW(P, B) cvtpk_s(P[B], P[B + 1])
#define PAF(k) __builtin_bit_cast(bf16x8, pw##k)
#define VFR(i) (bf16x8){vlo[i][0], vlo[i][1], vlo[i][2], vlo[i][3], vhi[i][0], vhi[i][1], vhi[i][2], vhi[i][3]}
#define PIN(x) asm volatile("" : "+v"(x))
#define MX3(a, b, c) __builtin_fmaxf(__builtin_fmaxf((a), (b)), (c))
#define GAPA(MF, A0, A1, A2, A3, W0, W1, PW) do { MF; sacc += A0; sacc += A1; sacc += A2; sacc += A3; PIN(sacc); W0; W1; PIN(PW); SBAR(); } while (0)
#define EX(v) __builtin_amdgcn_exp2f(v)
#define GAPB(MF, X, B) do { MF; X[B] = EX(X[B]); X[B + 1] = EX(X[B + 1]); X[B + 2] = EX(X[B + 2]); X[B + 3] = EX(X[B + 3]); PIN(X); SBAR(); } while (0)
#define VRD(i) do { vlo[i] = vtr(vp_ + (((i) >> 2) * 4096 + ((i) & 3) * 1024)); vhi[i] = vtr(vp_ + (((i) >> 2) * 4096 + ((i) & 3) * 1024 + 512)); } while (0)
#define KRD(G, j) do { if (G) { kload2(kf, kp0 + sl_next, j); SBAR(); } } while (0)
#define STEP(C0, C1, P0, P1, t, GK, GV, GL) do { SBAR(); \
    const lds_cptr vp_ = vp0 + sl_prev; \
    VRD(0); SBAR(); float sacc = (P0[0] + P0[1]); \
    GAPA(C0 = __builtin_amdgcn_mfma_f32_32x32x16_bf16(kf[0], qr[0], negm, 0, 0, 0), P0[2], P0[3], P0[4], P0[5],     pw0[0] = PKW(P0, 0), pw0[1] = PKW(P0, 2), pw0); \
    VRD(4); SBAR(); GAPA(C1 = __builtin_amdgcn_mfma_f32_32x32x16_bf16(kf[1], qr[0], negm, 0, 0, 0), P0[6], P0[7], P0[8], P0[9],     pw0[2] = PKW(P0, 4), pw0[3] = PKW(P0, 6), pw0); \
    VRD(1); SBAR(); GAPA(C0 = __builtin_amdgcn_mfma_f32_32x32x16_bf16(kf[2], qr[1], C0, 0, 0, 0),   P0[10], P0[11], P0[12], P0[13], pw1[0] = PKW(P0, 8), pw1[1] = PKW(P0, 10), pw1); \
    VRD(5); SBAR(); GAPA(C1 = __builtin_amdgcn_mfma_f32_32x32x16_bf16(kf[3], qr[1], C1, 0, 0, 0),   P0[14], P0[15], P1[0], P1[1],   pw1[2] = PKW(P0, 12), pw1[3] = PKW(P0, 14), pw1); \
    VRD(2); SBAR(); GAPA(C0 = __builtin_amdgcn_mfma_f32_32x32x16_bf16(kf[4], qr[2], C0, 0, 0, 0),   P1[2], P1[3], P1[4], P1[5],     pw2[0] = PKW(P1, 0), pw2[1] = PKW(P1, 2), pw2); \
    VRD(6); SBAR(); GAPA(C1 = __builtin_amdgcn_mfma_f32_32x32x16_bf16(kf[5], qr[2], C1, 0, 0, 0),   P1[6], P1[7], P1[8], P1[9],     pw2[2] = PKW(P1, 4), pw2[3] = PKW(P1, 6), pw2); \
    VRD(3); SBAR(); GAPA(C0 = __builtin_amdgcn_mfma_f32_32x32x16_bf16(kf[6], qr[3], C0, 0, 0, 0),   P1[10], P1[11], P1[12], P1[13], pw3[0] = PKW(P1, 8), pw3[1] = PKW(P1, 10), pw3); \
    VRD(7); SBAR(); GAPA(C1 = __builtin_amdgcn_mfma_f32_32x32x16_bf16(kf[7], qr[3], C1, 0, 0, 0),   P1[14], P1[15], 0.f, 0.f,       pw3[2] = PKW(P1, 12), pw3[3] = PKW(P1, 14), pw3); \
    l_reg += sacc; \
    if (GK) { DMA_K((t) + 3, sl_cur); } if (GV) { DMA_V((t) + 1, sl_next); } \
    CMASK(C0, C1, t); \
    { float a = MX3(C0[0], C0[1], C1[0]), b = MX3(C0[2], C0[3], C1[1]); a = MX3(a, C1[2], C1[3]); \
      _Pragma("unroll") for (int r = 4; r < 16; r += 4) { a = MX3(a, C0[r], C0[r + 1]); b = MX3(b, C0[r + 2], C0[r + 3]); a = MX3(a, C1[r], C1[r + 1]); b = MX3(b, C1[r + 2], C1[r + 3]); } \
      float rm = __builtin_fmaxf(a, b); { auto rr = __builtin_amdgcn_permlane32_swap(__float_as_uint(rm), __float_as_uint(rm), false, false); rm = __builtin_fmaxf(__uint_as_float(rr[0]), __uint_as_float(rr[1])); } \
      resc = false; \
      if (__builtin_expect(__any(rm > (float)THRL), 0)) { const float dl = __builtin_fmaxf(rm, 0.f); mhat += dl; \
        _Pragma("unroll") for (int r = 0; r < 16; ++r) { C0[r] -= dl; C1[r] -= dl; } \
        if constexpr (!NONEGM) { _Pragma("unroll") for (int r = 0; r < 16; ++r) negm[r] = -mhat; asm volatile("" : "+v"(negm)); } \
        const float f = __builtin_amdgcn_exp2f(-dl); l_reg *= f; if (hi == 0) wsf[r32] = f; resc = true; } } \
    SBAR(); \
    GAPB(o[0] = __builtin_amdgcn_mfma_f32_32x32x16_bf16(PAF(0), VFR(0), o[0], 0, 0, 0), C0, 0); \
    GAPB(o[1] = __builtin_amdgcn_mfma_f32_32x32x16_bf16(PAF(0), VFR(4), o[1], 0, 0, 0), C0, 4); \
    KRD(GL, 0); GAPB(o[0] = __builtin_amdgcn_mfma_f32_32x32x16_bf16(PAF(1), VFR(1), o[0], 0, 0, 0), C0, 8); \
    KRD(GL, 1); GAPB(o[1] = __builtin_amdgcn_mfma_f32_32x32x16_bf16(PAF(1), VFR(5), o[1], 0, 0, 0), C0, 12); \
    KRD(GL, 2); GAPB(o[0] = __builtin_amdgcn_mfma_f32_32x32x16_bf16(PAF(2), VFR(2), o[0], 0, 0, 0), C1, 0); \
    KRD(GL, 3); GAPB(o[1] = __builtin_amdgcn_mfma_f32_32x32x16_bf16(PAF(2), VFR(6), o[1], 0, 0, 0), C1, 4); \
    GAPB(o[0] = __builtin_amdgcn_mfma_f32_32x32x16_bf16(PAF(3), VFR(3), o[0], 0, 0, 0), C1, 8); \
    GAPB(o[1] = __builtin_amdgcn_mfma_f32_32x32x16_bf16(PAF(3), VFR(7), o[1], 0, 0, 0), C1, 12); \
    } while (0)
  int t = 1;
  for (; t + 5 < NT; t += 2) {
    STEP(pB0, pB1, pA0, pA1, t, true, true, true);     WAIT_BAR(2); RESC(); ROT();
    STEP(pA0, pA1, pB0, pB1, t + 1, true, true, true); WAIT_BAR(2); RESC(); ROT();
  }
#define ENDW(tt) do { if ((tt) + 3 < NT) { WAIT_BAR(2); } else if ((tt) + 2 < NT) { WAIT_BAR(1); } else { WAIT_BAR(0); } } while (0)
  for (; t + 1 < NT; t += 2) {
    STEP(pB0, pB1, pA0, pA1, t, (t + 3 < NT), (t + 1 < NT), (t + 1 < NT));         ENDW(t);     RESC(); ROT();
    STEP(pA0, pA1, pB0, pB1, t + 1, (t + 4 < NT), (t + 2 < NT), (t + 2 < NT));     ENDW(t + 1); RESC(); ROT();
  }
  STEP(pB0, pB1, pA0, pA1, NT - 1, false, false, false); RESC();
  { float sacc = pB0[0] + pB0[1]; _Pragma("unroll") for (int r = 2; r < 16; ++r) sacc += pB0[r]; _Pragma("unroll") for (int r = 0; r < 16; ++r) sacc += pB1[r]; l_reg += sacc;
    pw0 = (u32x4){PKW(pB0, 0), PKW(pB0, 2), PKW(pB0, 4), PKW(pB0, 6)}; pw1 = (u32x4){PKW(pB0, 8), PKW(pB0, 10), PKW(pB0, 12), PKW(pB0, 14)}; pw2 = (u32x4){PKW(pB1, 0), PKW(pB1, 2), PKW(pB1, 4), PKW(pB1, 6)}; pw3 = (u32x4){PKW(pB1, 8), PKW(pB1, 10), PKW(pB1, 12), PKW(pB1, 14)};
    SBAR(); pv(o, vb0 + sl_cur, PAF(0), PAF(1), PAF(2), PAF(3)); }
#undef PKW
#undef PAF
#undef VFR
#undef PIN
#undef MX3
#undef GAPA
#undef GAPB
#undef EX
#undef VRD
#undef KRD
#undef STEP
#undef ENDW
  { auto rr = __builtin_amdgcn_permlane32_swap(__float_as_uint(l_reg), __float_as_uint(l_reg), false, false); l_reg = __uint_as_float(rr[0]) + __uint_as_float(rr[1]); }
  if (hi == 0) wsf[32 + r32] = l_reg; asm volatile("s_waitcnt lgkmcnt(0)" ::: "memory");
  float rli[16];
#pragma unroll
  for (int r = 0; r < 16; ++r) rli[r] = __builtin_amdgcn_rcpf(wsf[32 + crow(r, hi)]);
  bf16* Ow = Ow0 + (long)(wid * QBLK) * OP;
  { bf16* stg = (bf16*)(shm + LDS_OST) + wid * 2048;
#pragma unroll
    for (int r = 0; r < 16; ++r) { const int orow = crow(r, hi);
#pragma unroll
      for (int d0 = 0; d0 < 2; ++d0) stg[orow * 64 + d0 * 32 + r32] = __float2bfloat16(o[d0][r] * rli[r]); }
    asm volatile("s_waitcnt lgkmcnt(0)" ::: "memory");
#pragma unroll
    for (int i = 0; i < 4; ++i) { const int row = i * 8 + (lane >> 3), ch = lane & 7; const u32x4 v = *(const u32x4*)(stg + row * 64 + ch * 8); *(u32x4*)(Ow + (long)row * OP + ch * 8) = v; } }
  asm volatile("s_waitcnt lgkmcnt(0)\n\ts_barrier" ::: "memory");
#undef DMA_K
#undef DMA_V
#undef CMASK
#undef START
#undef RESC
#undef ROT
}
#undef SBAR
#undef WAIT_BAR
}
#define XB_TMO      128
#define XB_XCNT(j)  (256  + 64 * (j))
#define XB_XSUB(j)  (1280 + 64 * (j))
#define XB_XGEN(j)  (2304 + 64 * (j))
#define XB_TOP      3328
#define XB_TOPGEN   3392
#define XCD_BAR_WORDS 3456
#define XB_SPIN_CAP (1u << 20)
__device__ __forceinline__ unsigned xb_ld(unsigned* p)              { return __hip_atomic_load(p, __ATOMIC_RELAXED, __HIP_MEMORY_SCOPE_AGENT); }
__device__ __forceinline__ unsigned xb_add(unsigned* p, unsigned v) { return __hip_atomic_fetch_add(p, v, __ATOMIC_RELAXED, __HIP_MEMORY_SCOPE_AGENT); }
__device__ __forceinline__ unsigned xb_xcc_id() { return (unsigned)__builtin_amdgcn_s_getreg((3 << 11) | 20) & 0xFu; }
#define XB_SPIN(cond, bar) do { unsigned _sp = 0; while (cond) { __builtin_amdgcn_s_sleep(1); \
    if ((++_sp & 255u) == 0u) { if (xb_ld(&(bar)[XB_TMO])) break; if (_sp > XB_SPIN_CAP) { atomicAdd(&(bar)[XB_TMO], 1u); break; } } } } while (0)
struct XcdBarrier { unsigned* bar; unsigned x; volatile LAS unsigned* st; };
__device__ __forceinline__ XcdBarrier xcd_barrier_post(unsigned* bar, volatile LAS unsigned* st) {
    XcdBarrier b; b.bar = bar; b.x = xb_xcc_id(); b.st = st;
    if (otid() == 0) (void)xb_add(&bar[XB_XCNT(b.x)], 1u);
    return b;
}
__device__ __forceinline__ void xcd_barrier_complete(unsigned* bar, unsigned x, unsigned& nloc, unsigned& nx) {
    const unsigned G = gridDim.x * gridDim.y * gridDim.z;
    unsigned sum, cnt, mine, sp = 0u;
    for (;;) {
        sum = 0u; cnt = 0u; mine = 0u;
#pragma unroll
        for (unsigned j = 0; j < 16; ++j) { const unsigned c = xb_ld(&bar[XB_XCNT(j)]); sum += c; cnt += (c > 0u) ? 1u : 0u; mine = (j == x) ? c : mine; }
        if (sum == G) break;
        __builtin_amdgcn_s_sleep(1);
        if ((++sp & 255u) == 0u) { if (xb_ld(&bar[XB_TMO])) break; if (sp > XB_SPIN_CAP) { atomicAdd(&bar[XB_TMO], 1u); break; } }
    }
    nloc = mine > 0u ? mine : 1u; nx = cnt > 0u ? cnt : 1u;
}
__device__ __forceinline__ void xcd_barrier(const XcdBarrier& b) {
    asm volatile("s_waitcnt vmcnt(0)" ::: "memory");
    __syncthreads();
    if (otid() == 0) {
        unsigned* bar = b.bar;
        __builtin_amdgcn_s_waitcnt(0);
        unsigned nloc = b.st[0], nx = b.st[1];
        if (nloc == 0u) { xcd_barrier_complete(bar, b.x, nloc, nx); b.st[0] = nloc; b.st[1] = nx; }
        const unsigned old = xb_add(&bar[XB_XSUB(b.x)], 1u);
        const unsigned gen = old / nloc;
        if (old + 1u == (gen + 1u) * nloc) {
            __builtin_amdgcn_fence(__ATOMIC_RELEASE, "agent");
            asm volatile("s_waitcnt vmcnt(0)" ::: "memory");
            const unsigned og = xb_add(&bar[XB_TOP], 1u);
            const unsigned tg = og / nx;
            if (og + 1u == (tg + 1u) * nx) xb_add(&bar[XB_TOPGEN], 1u);
            else XB_SPIN(xb_ld(&bar[XB_TOPGEN]) == tg, bar);
            __builtin_amdgcn_fence(__ATOMIC_ACQUIRE, "agent");
            xb_add(&bar[XB_XGEN(b.x)], 1u);
            asm volatile("s_waitcnt vmcnt(0)" ::: "memory");
        } else {
            XB_SPIN(xb_ld(&bar[XB_XGEN(b.x)]) == gen, bar);
            __builtin_amdgcn_fence(__ATOMIC_ACQUIRE, "agent");
            asm volatile("s_waitcnt vmcnt(0)" ::: "memory");
        }
    }
    __syncthreads();
}
constexpr size_t MiB = (size_t)1 << 20;
constexpr size_t WS_CTL = 0, CTL_BYTES = 1 * MiB;
constexpr size_t WS_MODV = 1 * MiB;
constexpr size_t WS_S5AL = WS_MODV + 256 * 1024;
constexpr size_t WS_ROUTE = 2 * MiB;
constexpr size_t WS_XCTX = 3 * MiB;
constexpr size_t WS_WG1 = 5 * MiB;
constexpr size_t WS_WBR = 23 * MiB;
constexpr size_t WS_WOUT = 27 * MiB;
constexpr size_t WS_WGLU = 29 * MiB;
constexpr size_t WS_S5BS = 30 * MiB;
constexpr size_t WS_S5BO = 38 * MiB;
constexpr size_t WS_HB = 62 * MiB;
constexpr size_t WS_A = 95 * MiB;
constexpr size_t WS_B = 405 * MiB;
constexpr size_t WS_C = 488 * MiB;
constexpr size_t WS_END = 540 * MiB;
constexpr size_t SZ512 = (size_t)RT * 512 * 2;
constexpr size_t A_UH = 0;
constexpr size_t A_P512 = 36 * MiB;
constexpr size_t A_GQK = A_P512 + 8 * SZ512, A_GQV = A_GQK + (size_t)RT * 128 * 2, A_MLG = A_GQV + (size_t)RT * 128 * 2;
constexpr size_t A_GATE = 178 * MiB;
constexpr size_t A_MSUM = 0;
constexpr size_t A_W13 = 0, A_W2 = 64 * MiB, A_MBUF = 96 * MiB, A_MH = 178 * MiB, A_MY = 219 * MiB;
static_assert(A_MLG + (size_t)RT * 16 * 4 <= A_GATE && A_GATE + (size_t)RT * 4096 * 2 <= 310 * MiB && A_MY + (size_t)MOE_MAXROWS * 1024 * 2 <= 310 * MiB, "region A");
constexpr size_t B_Z = 4 * SZ512;
constexpr size_t C_CST = 0, C_NST = 33 * MiB, C_DEC = C_NST + 768 * 1024, C_SST = 34 * MiB;
constexpr int CW_BAR = 4096, CW_CNT = 8192;
constexpr int NA_TAB_OFF = 86016;

__device__ __forceinline__ float* xrow_ptr(float* out, float* xctx, int row) { const int b = row / SB, s = row - b * SB; return s < CTX ? xctx + (size_t)(b * CTX + s) * DM : out + ((size_t)b * SEQ + (s - CTX)) * DM; }
__device__ __forceinline__ int modsel(int row) { const int b = row / SB, s = row - b * SB; return s < CTX ? 2 : b; }

template <class RowMap>
__device__ __forceinline__ void tr_item(const float* Wc, int ld, int k0, int nvalid, bf16_t* WT, int ldo, const RowMap rm, LAS float* scr, int lane) {
#pragma unroll 8
    for (int i = 0; i < 32; ++i) { const int kk = 2 * i + (lane >> 5), n = lane & 31; scr[kk * 33 + n] = (n < nvalid) ? Wc[(size_t)(k0 + kk) * ld + n] : 0.f; }
    asm volatile("s_waitcnt lgkmcnt(0)" ::: "memory");
    const int c = lane & 7;
#pragma unroll
    for (int j = 0; j < 4; ++j) { const int n = (lane >> 3) + 8 * j; const LAS float* s = scr + (8 * c) * 33 + n;
        u32x4 o; o.x = pk2(s[0 * 33], s[1 * 33]); o.y = pk2(s[2 * 33], s[3 * 33]); o.z = pk2(s[4 * 33], s[5 * 33]); o.w = pk2(s[6 * 33], s[7 * 33]);
        if (n < nvalid) *(u32x4*)(WT + (size_t)rm(n) * ldo + k0 + 8 * c) = o; }
    asm volatile("s_waitcnt lgkmcnt(0)" ::: "memory");
}
struct RmAffine { int r0; __device__ __forceinline__ int operator()(int n) const { return r0 + n; } };
struct RmMoe13 { int r0, n0; __device__ __forceinline__ int operator()(int n) const { const int h = n0 + n; return r0 + (h >> 2) * 8 + (h & 3); } };

__device__ __forceinline__ void conv_layer_weights(const float* w_in, const float* w_gate, const float* w_branch, const float* w_out, const float* w_glu,
                                                   unsigned char* ws, LAS float* scr, int gw, int NGW, int lane) {
    bf16_t* WG1 = (bf16_t*)(ws + WS_WG1); bf16_t* WBR = (bf16_t*)(ws + WS_WBR); bf16_t* WOUT = (bf16_t*)(ws + WS_WOUT); bf16_t* WGLU = (bf16_t*)(ws + WS_WGLU);
    constexpr int I1 = 16 * 128, I2 = 16, I3 = 16 * 24, I4 = 16 * 128, I5 = 4 * 8 * 32, I6 = 16 * 32, I7 = 8 * 16, NIT = I1 + I2 + I3 + I4 + I5 + I6 + I7;
    for (int it = gw; it < NIT; it += NGW) {
        int r = it;
        if (r < I1) { const int kb = r / 128, nb = r % 128; tr_item(w_in + 32 * nb, 4880, 64 * kb, 32, WG1, 1024, RmAffine{32 * nb}, scr, lane); continue; } r -= I1;
        if (r < I2) { tr_item(w_in + 4096, 4880, 64 * r, 16, WG1, 1024, RmAffine{4864}, scr, lane); continue; } r -= I2;
        if (r < I3) { const int kb = r / 24, nb = r % 24; tr_item(w_in + 4112 + 32 * nb, 4880, 64 * kb, 32, WG1, 1024, RmAffine{4096 + 32 * nb}, scr, lane); continue; } r -= I3;
        if (r < I4) { const int kb = r / 128, nb = r % 128; tr_item(w_gate + 32 * nb, 4096, 64 * kb, 32, WG1, 1024, RmAffine{5120 + 32 * nb}, scr, lane); continue; } r -= I4;
        if (r < I5) { const int i = r / 256, q = r % 256, kb = q / 32, nb = q % 32; tr_item(w_branch + (size_t)i * 512 * 1024 + 32 * nb, 1024, 64 * kb, 32, WBR + (size_t)i * 1024 * 512, 512, RmAffine{32 * nb}, scr, lane); continue; } r -= I5;
        if (r < I6) { const int kb = r / 32, nb = r % 32; tr_item(w_out + 32 * nb, 1024, 64 * kb, 32, WOUT, 1024, RmAffine{32 * nb}, scr, lane); continue; } r -= I6;
        { const int kb = r / 16, nb = r % 16; tr_item(w_glu + 32 * nb, 512, 64 * kb, 32, WGLU, 512, RmAffine{32 * nb}, scr, lane); }
    }
}
__device__ __forceinline__ void conv_moe_weights(const float* w1, const float* w3, const float* w2, unsigned char* ws, LAS float* scr, int gw, int NGW, int lane) {
    bf16_t* W13 = (bf16_t*)(ws + WS_A + A_W13); bf16_t* W2T = (bf16_t*)(ws + WS_A + A_W2);
    constexpr int PER = 256 + 256 + 256, NIT = 32 * PER;
    for (int it = gw; it < NIT; it += NGW) {
        const int e = it / PER; int r = it % PER;
        if (r < 256) { const int kb = r / 16, nb = r % 16; tr_item(w1 + (size_t)e * 1024 * 512 + 32 * nb, 512, 64 * kb, 32, W13, 1024, RmMoe13{e * 1024, 32 * nb}, scr, lane); continue; } r -= 256;
        if (r < 256) { const int kb = r / 16, nb = r % 16; tr_item(w3 + (size_t)e * 1024 * 512 + 32 * nb, 512, 64 * kb, 32, W13, 1024, RmMoe13{e * 1024 + 4, 32 * nb}, scr, lane); continue; } r -= 256;
        { const int kb = r / 32, nb = r % 32; tr_item(w2 + (size_t)e * 512 * 1024 + 32 * nb, 1024, 64 * kb, 32, W2T, 512, RmAffine{e * 1024 + 32 * nb}, scr, lane); }
    }
}

__device__ __forceinline__ void s5_precompute(int l, int g, const float* lam_re, const float* lam_im, const float* log_dt, const float* b_re, const float* b_im,
                                              const float* c_re, const float* c_im, const float* d_skip, unsigned char* ws, LAS unsigned char* lds) {
    const int tid = otid();
    LAS f32x2* apw = (LAS f32x2*)lds;
    LAS f32x2* bbar = (LAS f32x2*)(lds + 33792);
    LAS f32x2* ccv = (LAS f32x2*)(lds + 33792 + 16384);
    LAS float* Kt = (LAS float*)(lds + 33792 + 32768);
    float* AL = (float*)(ws + WS_S5AL);
    if (tid < 128) {
        const int d = tid >> 6, p = tid & 63; const size_t gi = ((size_t)(l * 2 + d) * 32 + g);
        const float dt = __expf(log_dt[gi]); const float lr = lam_re[gi * 64 + p], li = lam_im[gi * 64 + p];
        for (int tau = 0; tau <= 32; ++tau) { const float mag = __expf((float)tau * lr * dt), ang = (float)tau * li * dt; apw[(d * 64 + p) * 33 + tau] = (f32x2){mag * __cosf(ang), mag * __sinf(ang)}; }
        const f32x2 a = apw[(d * 64 + p) * 33 + 1]; const float nr = a.x - 1.f, den = lr * lr + li * li;
        const float fr_ = (nr * lr + a.y * li) / den, fi_ = (a.y * lr - nr * li) / den;
        for (int ch = 0; ch < 16; ++ch) { const float br = b_re[(gi * 64 + p) * 16 + ch], bi = b_im[(gi * 64 + p) * 16 + ch]; bbar[(d * 64 + p) * 16 + ch] = (f32x2){fr_ * br - fi_ * bi, fr_ * bi + fi_ * br}; }
        for (int ch = 0; ch < 16; ++ch) ccv[(d * 16 + ch) * 64 + p] = (f32x2){c_re[(gi * 16 + ch) * 64 + p], c_im[(gi * 16 + ch) * 64 + p]};
        const f32x2 a32 = apw[(d * 64 + p) * 33 + 32]; AL[((d * 32 + g) * 64 + p) * 2 + 0] = a32.x; AL[((d * 32 + g) * 64 + p) * 2 + 1] = a32.y;
    }
    __syncthreads();
    for (int e = tid; e < 2 * 32 * 256; e += 512) {
        const int d = e >> 13, tau = (e >> 8) & 31, ch = (e >> 4) & 15, c2 = e & 15; float s = 0.f;
        for (int p = 0; p < 64; ++p) { const f32x2 c = ccv[(d * 16 + ch) * 64 + p], a = apw[(d * 64 + p) * 33 + tau], bb = bbar[(d * 64 + p) * 16 + c2];
            const float car = c.x * a.x - c.y * a.y, cai = c.x * a.y + c.y * a.x; s += car * bb.x - cai * bb.y; }
        Kt[e] = s;
    }
    __syncthreads();
    bf16_t* BO = (bf16_t*)(ws + WS_S5BO) + (size_t)g * 512 * 768;
    for (int q = tid; q < 512 * 96; q += 512) {
        const int n = q / 96, k8 = (q % 96) * 8, j = n >> 4, ch = n & 15; float v[8];
        if (k8 < 512) { const int i = k8 >> 4, c0 = k8 & 15;
#pragma unroll
            for (int e = 0; e < 8; ++e) { float t = 0.f; if (j >= i) t += Kt[((0 * 32 + (j - i)) * 16 + ch) * 16 + c0 + e]; if (i >= j) t += Kt[((1 * 32 + (i - j)) * 16 + ch) * 16 + c0 + e];
                if (i == j && ch == c0 + e) t += d_skip[l * 512 + g * 16 + ch]; v[e] = t; }
        } else { const int d = (k8 >= 640) ? 1 : 0, p0 = ((k8 - 512) & 127) >> 1, tau = d ? (32 - j) : (j + 1);
#pragma unroll
            for (int e = 0; e < 4; ++e) { const f32x2 c = ccv[(d * 16 + ch) * 64 + p0 + e], a = apw[(d * 64 + p0 + e) * 33 + tau]; v[2 * e] = c.x * a.x - c.y * a.y; v[2 * e + 1] = -(c.x * a.y + c.y * a.x); }
        }
        u32x4 o; o.x = pk2(v[0], v[1]); o.y = pk2(v[2], v[3]); o.z = pk2(v[4], v[5]); o.w = pk2(v[6], v[7]);
        *(u32x4*)(BO + (size_t)n * 768 + k8) = o;
    }
    bf16_t* BS = (bf16_t*)(ws + WS_S5BS) + (size_t)g * 256 * 512;
    for (int q = tid; q < 256 * 64; q += 512) {
        const int n = q >> 6, k8 = (q & 63) * 8, d = n >> 7, p = (n >> 1) & 63, ri = n & 1, i = k8 >> 4, c0 = k8 & 15, tau = d ? i : (31 - i); float v[8];
        const f32x2 a = apw[(d * 64 + p) * 33 + tau];
#pragma unroll
        for (int e = 0; e < 8; ++e) { const f32x2 bb = bbar[(d * 64 + p) * 16 + c0 + e]; v[e] = ri ? (a.x * bb.y + a.y * bb.x) : (a.x * bb.x - a.y * bb.y); }
        u32x4 o; o.x = pk2(v[0], v[1]); o.y = pk2(v[2], v[3]); o.z = pk2(v[4], v[5]); o.w = pk2(v[6], v[7]);
        *(u32x4*)(BS + (size_t)n * 512 + k8) = o;
    }
    __syncthreads();
}

__device__ __forceinline__ void modv_item(int item, const float* w_mod, const float* b_mod, float* MODV, const LAS float* scs, int lane) {
    const int l = item / 96, col = (item % 96) * 64 + lane; const float* w = w_mod + (size_t)l * 1024 * 6144 + col;
    float a0 = 0.f, a1 = 0.f, a2 = 0.f;
#pragma unroll 8
    for (int k = 0; k < 1024; ++k) { const float wv = w[(size_t)k * 6144]; a0 += scs[k] * wv; a1 += scs[1024 + k] * wv; a2 += scs[2048 + k] * wv; }
    const float bb = b_mod[l * 6144 + col];
    MODV[(l * 3 + 0) * 6144 + col] = a0 + bb; MODV[(l * 3 + 1) * 6144 + col] = a1 + bb; MODV[(l * 3 + 2) * 6144 + col] = a2 + bb;
}

__device__ __forceinline__ void norm_mod_row(const float* xrow, const float* g, const float* shift, const float* scale, bf16_t* orow, int lane, f32x4 (&v)[4]) {
    float s = 0.f;
#pragma unroll
    for (int j = 0; j < 4; ++j) { v[j] = ((const f32x4*)xrow)[lane + 64 * j]; s += (v[j].x * v[j].x + v[j].y * v[j].y) + (v[j].z * v[j].z + v[j].w * v[j].w); }
    const float rstd = rsqrtf(wave_sum(s) * (1.f / DM) + 1e-6f);
#pragma unroll
    for (int j = 0; j < 4; ++j) { const f32x4 gg = ((const f32x4*)g)[lane + 64 * j], sh = ((const f32x4*)shift)[lane + 64 * j], sc = ((const f32x4*)scale)[lane + 64 * j];
        v[j] = (v[j] * rstd * gg) * (sc + 1.f) + sh;
        u32x2 o; o.x = pk2(v[j].x, v[j].y); o.y = pk2(v[j].z, v[j].w); ((u32x2*)orow)[lane + 64 * j] = o; }
}
struct GridOrder {
    int nM, nN, nwg, G, c, skipctx;
    __device__ __forceinline__ void init(int nM_, int nN_, int G_, int c_, int skip_) { nM = nM_; nN = nN_; nwg = nM * nN; G = G_; c = c_; skipctx = skip_; }
    __device__ __forceinline__ bool tile(long L, int& pm, int& pn) const {
        if (L >= nwg) return false;
        int wgid = (int)L; { const int q = nwg / 8, r = nwg % 8, xcd = wgid % 8, off = wgid / 8; wgid = (xcd < r ? xcd * (q + 1) : r * (q + 1) + (xcd - r) * q) + off; }
        const int nig = 8 * nN, gid = wgid / nig, fm = gid * 8, gsz = (nM - fm) < 8 ? (nM - fm) : 8;
        pm = fm + ((wgid % nig) % gsz); pn = (wgid % nig) / gsz;
        if (skipctx) pm = (pm >> 5) * 33 + 1 + (pm & 31);
        return true;
    }
    __device__ __forceinline__ bool next(int i, pg8::Unit& u) const { u.z = 0; u.pad = 0; u.aoff = 0; u.boff = 0; return tile((long)i * G + c, u.pm, u.pn); }
};
struct QuadOrder : GridOrder {
    __device__ __forceinline__ bool next(int i, pg8::Unit& u) const { u.z = i & 3; u.pad = 0; u.aoff = (long)u.z * (long)SZ512; u.boff = (long)u.z * 1024 * 512 * 2; return tile((long)(i >> 2) * G + c, u.pm, u.pn); }
};
template <int NJ> struct S5Order {
    int G, c;
    __device__ __forceinline__ bool next(int i, pg8::Unit& u) const { const int L = i * G + c; if (L >= 32 * 3 * NJ) return false; const int g = L / (3 * NJ), r = L % (3 * NJ); u.pm = 3 * g + r / NJ; u.pn = g * NJ + r % NJ; u.z = g; u.pad = 0; u.aoff = 0; u.boff = 0; return true; }
};
struct MoeOrder {
    int G, c, ntiles; const LAS int* texp;
    __device__ __forceinline__ bool next(int i, pg8::Unit& u) const { const int L = i * G + c; if (L >= ntiles * 4) return false; const int mt = L >> 2, j = L & 3; u.pm = mt; u.pn = texp[mt] * 4 + j; u.z = j; u.pad = 0; u.aoff = 0; u.boff = 0; return true; }
};

#define EPI_ARGS const f32x4 (&acc)[2][2][4][2], const pg8::Unit& u, int wr, int wc, int fr, int fq
#define EPI_LOOP_BEGIN  _Pragma("unroll") for (int ai = 0; ai < 2; ++ai) _Pragma("unroll") for (int m = 0; m < 4; ++m) { const int r = u.pm * 256 + ai * 128 + wr * 64 + m * 16 + fr; \
                        _Pragma("unroll") for (int bj = 0; bj < 2; ++bj) { const int ct = bj * 128 + wc * 32 + 8 * fq; f32x4 v0 = acc[ai][bj][m][0], v1 = acc[ai][bj][m][1];
#define EPI_LOOP_END    } }
__device__ __forceinline__ u32x4 pack8(f32x4 v0, f32x4 v1) { u32x4 w; w.x = pg8::cvt_pk_bf16(v0[0], v0[1]); w.y = pg8::cvt_pk_bf16(v0[2], v0[3]); w.z = pg8::cvt_pk_bf16(v1[0], v1[1]); w.w = pg8::cvt_pk_bf16(v1[2], v1[3]); return w; }

struct EpiG1 {
    unsigned char* ws; const float* b_gates; const float* b_gate;
    __device__ __forceinline__ void operator()(EPI_ARGS) const {
        const int pn = u.pn; unsigned char* A = ws + WS_A;
        if (pn < 2) {
            bf16_t* UH = (bf16_t*)(A + A_UH);
            EPI_LOOP_BEGIN
                const int cu = pn * 256 + ct, g = cu >> 4, ch0 = cu & 15; const int b = r / SB, s = r - b * SB, cc = s >> 5, j = s & 31;
                *(u32x4*)(UH + ((size_t)(g * S5RP + b * S5NC + cc)) * 768 + j * 16 + ch0) = pack8(v0, v1);
            EPI_LOOP_END
        } else if (pn < 18) {
            const int bi = (pn - 2) >> 1; bf16_t* P = (bf16_t*)(A + A_P512 + (size_t)bi * SZ512); const float sc = (bi == 0) ? 0.125f * LOG2E : (bi == 4 ? 0.08838834764831845f : 1.f);
            EPI_LOOP_BEGIN
                *(u32x4*)(P + (size_t)r * 512 + (pn & 1) * 256 + ct) = pack8(v0 * sc, v1 * sc);
            EPI_LOOP_END
        } else if (pn == 18) {
            EPI_LOOP_BEGIN
                bf16_t* P = (bf16_t*)(A + (bj ? A_GQV : A_GQK));
                *(u32x4*)(P + (size_t)r * 128 + wc * 32 + 8 * fq) = pack8(v0, v1);
            EPI_LOOP_END
        } else if (pn == 19) {
            float* MLG = (float*)(A + A_MLG);
            if (wc == 0 && fq < 2) {
#pragma unroll
                for (int ai = 0; ai < 2; ++ai)
#pragma unroll
                    for (int m = 0; m < 4; ++m) { const int r = u.pm * 256 + ai * 128 + wr * 64 + m * 16 + fr; f32x4 v0 = acc[ai][0][m][0], v1 = acc[ai][0][m][1];
                        const int c0 = 8 * fq;
                        v0 = v0 + *(const f32x4*)(b_gates + c0); v1 = v1 + *(const f32x4*)(b_gates + c0 + 4);
                        v1 = (f32x4){log_sigmoidf_(v1[0]), log_sigmoidf_(v1[1]), log_sigmoidf_(v1[2]), log_sigmoidf_(v1[3])};
                        *(f32x4*)(MLG + (size_t)r * 16 + c0) = v0; *(f32x4*)(MLG + (size_t)r * 16 + c0 + 4) = v1; }
            }
        } else {
            bf16_t* GT = (bf16_t*)(A + A_GATE); const int gc0 = (pn - 20) * 256;
            EPI_LOOP_BEGIN
                const int c = gc0 + ct; const f32x4 b0 = *(const f32x4*)(b_gate + c), b1 = *(const f32x4*)(b_gate + c + 4);
                v0 = v0 + b0; v1 = v1 + b1;
                v0 = (f32x4){sigmoidf_(v0[0]), sigmoidf_(v0[1]), sigmoidf_(v0[2]), sigmoidf_(v0[3])}; v1 = (f32x4){sigmoidf_(v1[0]), sigmoidf_(v1[1]), sigmoidf_(v1[2]), sigmoidf_(v1[3])};
                *(u32x4*)(GT + (size_t)r * 4096 + c) = pack8(v0, v1);
            EPI_LOOP_END
        }
    }
};
struct EpiS5State {
    float* SST;
    __device__ __forceinline__ void operator()(EPI_ARGS) const {
        const int g = u.z, mi = u.pm - 3 * g;
        EPI_LOOP_BEGIN
            const int rr = mi * 256 + (r - u.pm * 256);
            if (rr < S5ROWS) { float* p = SST + ((size_t)g * S5ROWS + rr) * 256 + ct; *(f32x4*)p = v0; *(f32x4*)(p + 4) = v1; }
        EPI_LOOP_END
    }
};
struct EpiS5Out {
    bf16_t* Z;
    __device__ __forceinline__ void operator()(EPI_ARGS) const {
        const int g = u.z, mi = u.pm - 3 * g, nj = u.pn - 2 * g;
        EPI_LOOP_BEGIN
            const int rr = mi * 256 + (r - u.pm * 256);
            if (rr < S5ROWS) { const int n = nj * 256 + ct, j = n >> 4, ch0 = n & 15, b = rr / S5NC, cc = rr - b * S5NC; const size_t row = (size_t)b * SB + cc * 32 + j;
                v0 = (f32x4){gelu_tanh(v0[0]), gelu_tanh(v0[1]), gelu_tanh(v0[2]), gelu_tanh(v0[3])}; v1 = (f32x4){gelu_tanh(v1[0]), gelu_tanh(v1[1]), gelu_tanh(v1[2]), gelu_tanh(v1[3])};
                *(u32x4*)(Z + row * 512 + g * 16 + ch0) = pack8(v0, v1); }
        EPI_LOOP_END
    }
};
struct EpiGlu {
    const bf16_t* Z; bf16_t* YA; const float* b_glu;
    __device__ __forceinline__ void operator()(EPI_ARGS) const {
        EPI_LOOP_BEGIN
            const int c = u.pn * 256 + ct; const u32x4 z = *(const u32x4*)(Z + (size_t)r * 512 + c); const f32x4 b0 = *(const f32x4*)(b_glu + c), b1 = *(const f32x4*)(b_glu + c + 4);
            v0 = v0 + b0; v1 = v1 + b1;
            v0 = (f32x4){bflo(z.x) * sigmoidf_(v0[0]), bfhi(z.x) * sigmoidf_(v0[1]), bflo(z.y) * sigmoidf_(v0[2]), bfhi(z.y) * sigmoidf_(v0[3])};
            v1 = (f32x4){bflo(z.z) * sigmoidf_(v1[0]), bfhi(z.z) * sigmoidf_(v1[1]), bflo(z.w) * sigmoidf_(v1[2]), bfhi(z.w) * sigmoidf_(v1[3])};
            *(u32x4*)(YA + (size_t)r * 512 + c) = pack8(v0, v1);
        EPI_LOOP_END
    }
};
struct EpiMerge {
    const bf16_t* GT; float* MSUM; bf16_t* HB;
    __device__ __forceinline__ void operator()(EPI_ARGS) const {
        const int z = u.z;
        EPI_LOOP_BEGIN
            const int c = u.pn * 256 + ct; const u32x4 gq = *(const u32x4*)(GT + (size_t)r * 4096 + z * 1024 + c);
            v0 = v0 * (f32x4){bflo(gq.x), bfhi(gq.x), bflo(gq.y), bfhi(gq.y)}; v1 = v1 * (f32x4){bflo(gq.z), bfhi(gq.z), bflo(gq.w), bfhi(gq.w)};
            float* mp = MSUM + (size_t)r * 1024 + c;
            if (z > 0) { v0 = v0 + *(const f32x4*)mp; v1 = v1 + *(const f32x4*)(mp + 4); }
            if (z < 3) { *(f32x4*)mp = v0; *(f32x4*)(mp + 4) = v1; } else *(u32x4*)(HB + (size_t)r * 1024 + c) = pack8(v0, v1);
        EPI_LOOP_END
    }
};
struct EpiWout {
    float* out; float* xctx; const float* modl;
    __device__ __forceinline__ void operator()(EPI_ARGS) const {
        EPI_LOOP_BEGIN
            const int c = u.pn * 256 + ct; float* xp = xrow_ptr(out, xctx, r) + c; const float* mp = modl + modsel(r) * 6144 + 2 * 1024 + c;
            const f32x4 m0 = *(const f32x4*)mp, m1 = *(const f32x4*)(mp + 4);
            *(f32x4*)xp = *(const f32x4*)xp + m0 * v0; *(f32x4*)(xp + 4) = *(const f32x4*)(xp + 4) + m1 * v1;
        EPI_LOOP_END
    }
};
struct EpiMoe1 {
    bf16_t* MH;
    __device__ __forceinline__ void operator()(EPI_ARGS) const {
        EPI_LOOP_BEGIN
            const int hcol = u.z * 128 + (ct >> 1);
            f32x4 hh = (f32x4){v0[0] * sigmoidf_(v0[0]) * v1[0], v0[1] * sigmoidf_(v0[1]) * v1[1], v0[2] * sigmoidf_(v0[2]) * v1[2], v0[3] * sigmoidf_(v0[3]) * v1[3]};
            u32x2 w; w.x = pg8::cvt_pk_bf16(hh[0], hh[1]); w.y = pg8::cvt_pk_bf16(hh[2], hh[3]);
            *(u32x2*)(MH + (size_t)r * 512 + hcol) = w;
        EPI_LOOP_END
    }
};
struct EpiMoe2 {
    bf16_t* MY;
    __device__ __forceinline__ void operator()(EPI_ARGS) const {
        EPI_LOOP_BEGIN
            *(u32x4*)(MY + (size_t)r * 1024 + u.z * 256 + ct) = pack8(v0, v1);
        EPI_LOOP_END
    }
};

constexpr int MLS = 136;
__device__ __forceinline__ void lds_gemm128(f32x4 (&acc)[2][4], const LAS bf16_t* A, const LAS bf16_t* Bt, int wm, int wn, int fr, int fq) {
#pragma unroll
    for (int ks = 0; ks < 4; ++ks) {
        bf16x8 a[2], b[4];
#pragma unroll
        for (int mi = 0; mi < 2; ++mi) a[mi] = *(const LAS bf16x8*)(A + (32 * wm + 16 * mi + fr) * MLS + ks * 32 + fq * 8);
#pragma unroll
        for (int ni = 0; ni < 4; ++ni) b[ni] = *(const LAS bf16x8*)(Bt + (64 * wn + 16 * ni + fr) * MLS + ks * 32 + fq * 8);
#pragma unroll
        for (int mi = 0; mi < 2; ++mi)
#pragma unroll
            for (int ni = 0; ni < 4; ++ni) acc[mi][ni] = __builtin_amdgcn_mfma_f32_16x16x32_bf16(a[mi], b[ni], acc[mi][ni], 0, 0, 0);
    }
}
__device__ __forceinline__ int ml_idx(int b, int d, int h, int cc) { return ((b * 2 + d) * 4 + h) * MLNC + cc; }
__device__ __forceinline__ int ml_prev(int d, int cc) { if (d == 0) return cc - 1; if (cc == 1) return -1; if (cc == 0) return 1; if (cc == 65) return 0; return cc + 1; }
__device__ __forceinline__ int ml_order(int d, int s) { if (d == 0) return s; if (s == 0) return 1; if (s == 1) return 0; return 67 - s; }

__device__ __forceinline__ float ml_gates(const float* MLG, int r0, int d, int h, LAS float* lf_s, LAS float* ev, LAS float* fs, LAS float* wv) {
    const int tid = otid(); float li = 0.f, lf = 0.f;
    if (tid < 128) { li = MLG[(size_t)(r0 + tid) * 16 + d * 8 + h]; lf = MLG[(size_t)(r0 + tid) * 16 + d * 8 + 4 + h]; lf_s[tid] = lf; }
    __syncthreads();
    float tot = 0.f;
    if (tid < 128) { float c = 0.f; for (int i = 0; i < 128; ++i) { const float x = lf_s[i]; tot += x; if (d == 0 ? (i <= tid) : (i >= tid)) c += x; }
        ev[tid] = c; fs[tid] = c - li; wv[tid] = __expf(tot - c + li); }
    __syncthreads();
    float t2 = 0.f; for (int i = 0; i < 128; ++i) t2 += lf_s[i];
    return t2;
}
__device__ __forceinline__ void ml_stage_a(int b, int h, int cc, int d, const bf16_t* MLK, const bf16_t* MLV, const float* MLG, bf16_t* CST, float* NST, float* DEC, LAS unsigned char* lds) {
    const int tid = otid(), lane = tid & 63, wid = tid >> 6, wm = wid >> 1, wn = wid & 1, fr = lane & 15, fq = lane >> 4;
    LAS bf16_t* VT = (LAS bf16_t*)lds; LAS bf16_t* KT = (LAS bf16_t*)(lds + 128 * MLS * 2);
    LAS float* lf_s = (LAS float*)(lds + 4 * 128 * MLS * 2); LAS float* ev = lf_s + 128; LAS float* fs = ev + 128; LAS float* wv = fs + 128;
    const int r0 = b * SB + cc * MLC; const int idx = ml_idx(b, d, h, cc);
    const float tot = ml_gates(MLG, r0, d, h, lf_s, ev, fs, wv);
    if (tid == 0) DEC[idx] = __expf(tot);
#pragma unroll
    for (int i = 0; i < 4; ++i) { const int q = tid + 512 * i, t = q >> 4, c8 = (q & 15) * 8;
        const u32x4 kv = *(const u32x4*)(MLK + (size_t)(r0 + t) * 512 + h * 128 + c8), vv = *(const u32x4*)(MLV + (size_t)(r0 + t) * 512 + h * 128 + c8); const float w = wv[t];
        const unsigned kk[4] = {kv.x, kv.y, kv.z, kv.w}, vw[4] = {vv.x, vv.y, vv.z, vv.w};
#pragma unroll
        for (int e = 0; e < 4; ++e) { KT[(c8 + 2 * e) * MLS + t] = (bf16_t)(kk[e] & 0xffffu); KT[(c8 + 2 * e + 1) * MLS + t] = (bf16_t)(kk[e] >> 16);
            VT[(c8 + 2 * e) * MLS + t] = (bf16_t)f2bf(bflo(vw[e]) * w); VT[(c8 + 2 * e + 1) * MLS + t] = (bf16_t)f2bf(bfhi(vw[e]) * w); } }
    __syncthreads();
    f32x4 acc[2][4];
#pragma unroll
    for (int mi = 0; mi < 2; ++mi)
#pragma unroll
        for (int ni = 0; ni < 4; ++ni) acc[mi][ni] = (f32x4){0.f, 0.f, 0.f, 0.f};
    lds_gemm128(acc, VT, KT, wm, wn, fr, fq);
    bf16_t* G = CST + (size_t)idx * 16384;
#pragma unroll
    for (int mi = 0; mi < 2; ++mi)
#pragma unroll
        for (int ni = 0; ni < 4; ++ni)
#pragma unroll
            for (int rg = 0; rg < 4; ++rg) G[(32 * wm + 16 * mi + 4 * fq + rg) * 128 + 64 * wn + 16 * ni + fr] = (bf16_t)f2bf(acc[mi][ni][rg]);
    if (tid < 128) { float s = 0.f; for (int t = 0; t < 128; ++t) s += wv[t] * bf2f(KT[tid * MLS + t]); NST[(size_t)idx * 128 + tid] = s; }
    __syncthreads();
}
__device__ __forceinline__ void ml_scan(bf16_t* CST, float* NST, const float* DEC, int gtid, int nthreads) {
    for (int q = gtid; q < 16 * 8192; q += nthreads) {
        const int seq = q >> 13, e2 = (q & 8191) * 2, b = seq >> 3, d = (seq >> 2) & 1, h = seq & 3; float s0 = 0.f, s1 = 0.f;
        for (int s = 0; s < MLNC; s += 6) { unsigned g[6]; float dc[6];
#pragma unroll
            for (int k = 0; k < 6; ++k) { const int idx = ml_idx(b, d, h, ml_order(d, s + k)); g[k] = *(const unsigned*)(CST + (size_t)idx * 16384 + e2); dc[k] = DEC[idx]; }
#pragma unroll
            for (int k = 0; k < 6; ++k) { const int idx = ml_idx(b, d, h, ml_order(d, s + k)); s0 = dc[k] * s0 + bflo(g[k]); s1 = dc[k] * s1 + bfhi(g[k]); *(unsigned*)(CST + (size_t)idx * 16384 + e2) = pk2(s0, s1); } }
    }
    for (int q = gtid; q < 16 * 128; q += nthreads) {
        const int seq = q >> 7, e = q & 127, b = seq >> 3, d = (seq >> 2) & 1, h = seq & 3; float s0 = 0.f;
        for (int s = 0; s < MLNC; ++s) { const int idx = ml_idx(b, d, h, ml_order(d, s)); s0 = DEC[idx] * s0 + NST[(size_t)idx * 128 + e]; NST[(size_t)idx * 128 + e] = s0; }
    }
}
__device__ __forceinline__ void ml_stage_c(int b, int h, int cc, const bf16_t* MLQ, const bf16_t* MLK, const bf16_t* MLV, const bf16_t* MLO, const float* MLG, const bf16_t* CST, const float* NST,
                                           const float* g_norm, bf16_t* YM, LAS unsigned char* lds) {
    const int tid = otid(), lane = tid & 63, wid = tid >> 6, wm = wid >> 1, wn = wid & 1, fr = lane & 15, fq = lane >> 4;
    LAS bf16_t* Qs = (LAS bf16_t*)lds; LAS bf16_t* Ks = (LAS bf16_t*)(lds + 128 * MLS * 2); LAS bf16_t* VT = (LAS bf16_t*)(lds + 2 * 128 * MLS * 2); LAS bf16_t* Cp = (LAS bf16_t*)(lds + 3 * 128 * MLS * 2);
    LAS float* lf_s = (LAS float*)(lds + 4 * 128 * MLS * 2); LAS float* ev = lf_s + 128; LAS float* fs = ev + 128; LAS float* wv = fs + 128; LAS float* npv = wv + 128; LAS float* den = npv + 128; LAS float* part = den + 128;
    const int r0 = b * SB + cc * MLC;
    f32x4 hsum[2][4];
#pragma unroll
    for (int mi = 0; mi < 2; ++mi)
#pragma unroll
        for (int ni = 0; ni < 4; ++ni) hsum[mi][ni] = (f32x4){0.f, 0.f, 0.f, 0.f};
    for (int d = 0; d < 2; ++d) {
        (void)ml_gates(MLG, r0, d, h, lf_s, ev, fs, wv);
        const int pc = ml_prev(d, cc); const bf16_t* Cg = (pc >= 0) ? CST + (size_t)ml_idx(b, d, h, pc) * 16384 : nullptr;
        if (tid < 128) npv[tid] = (pc >= 0) ? NST[(size_t)ml_idx(b, d, h, pc) * 128 + tid] : 0.f;
#pragma unroll
        for (int i = 0; i < 4; ++i) { const int q = tid + 512 * i, t = q >> 4, c8 = (q & 15) * 8;
            *(LAS u32x4*)(Qs + t * MLS + c8) = *(const u32x4*)(MLQ + (size_t)(r0 + t) * 512 + h * 128 + c8);
            *(LAS u32x4*)(Ks + t * MLS + c8) = *(const u32x4*)(MLK + (size_t)(r0 + t) * 512 + h * 128 + c8);
            *(LAS u32x4*)(Cp + t * MLS + c8) = Cg ? *(const u32x4*)(Cg + t * 128 + c8) : (u32x4){0u, 0u, 0u, 0u};
            const u32x4 vv = *(const u32x4*)(MLV + (size_t)(r0 + t) * 512 + h * 128 + c8); const unsigned vw[4] = {vv.x, vv.y, vv.z, vv.w};
#pragma unroll
            for (int e = 0; e < 4; ++e) { VT[(c8 + 2 * e) * MLS + t] = (bf16_t)(vw[e] & 0xffffu); VT[(c8 + 2 * e + 1) * MLS + t] = (bf16_t)(vw[e] >> 16); } }
        __syncthreads();
        f32x4 acc[2][4];
#pragma unroll
        for (int mi = 0; mi < 2; ++mi)
#pragma unroll
            for (int ni = 0; ni < 4; ++ni) acc[mi][ni] = (f32x4){0.f, 0.f, 0.f, 0.f};
        lds_gemm128(acc, Qs, Ks, wm, wn, fr, fq);
        __syncthreads();
#pragma unroll
        for (int mi = 0; mi < 2; ++mi)
#pragma unroll
            for (int ni = 0; ni < 4; ++ni) { const int s = 64 * wn + 16 * ni + fr; const float fss = fs[s];
#pragma unroll
                for (int rg = 0; rg < 4; ++rg) { const int t = 32 * wm + 16 * mi + 4 * fq + rg; const bool ok = (d == 0) ? (s <= t) : (s >= t);
                    const float p = ok ? acc[mi][ni][rg] * __expf(ev[t] - fss) : 0.f; Ks[t * MLS + s] = (bf16_t)f2bf(p); } }
#pragma unroll
        for (int i = 0; i < 4; ++i) { const int q = tid + 512 * i, t = q >> 4, c8 = (q & 15) * 8; const float sc = __expf(ev[t]);
            u32x4 qv = *(LAS u32x4*)(Qs + t * MLS + c8);
            qv.x = pk2(bflo(qv.x) * sc, bfhi(qv.x) * sc); qv.y = pk2(bflo(qv.y) * sc, bfhi(qv.y) * sc); qv.z = pk2(bflo(qv.z) * sc, bfhi(qv.z) * sc); qv.w = pk2(bflo(qv.w) * sc, bfhi(qv.w) * sc);
            *(LAS u32x4*)(Qs + t * MLS + c8) = qv; }
        __syncthreads();
        { const int t = tid >> 2, q4 = tid & 3; float s = 0.f;
            for (int j = 0; j < 32; ++j) { const int c = q4 * 32 + j; s += bf2f(Ks[t * MLS + c]) + bf2f(Qs[t * MLS + c]) * npv[c]; }
            s += __shfl_xor(s, 1); s += __shfl_xor(s, 2); if (q4 == 0) den[t] = s; }
#pragma unroll
        for (int mi = 0; mi < 2; ++mi)
#pragma unroll
            for (int ni = 0; ni < 4; ++ni) acc[mi][ni] = (f32x4){0.f, 0.f, 0.f, 0.f};
        lds_gemm128(acc, Ks, VT, wm, wn, fr, fq);
        lds_gemm128(acc, Qs, Cp, wm, wn, fr, fq);
        __syncthreads();
#pragma unroll
        for (int mi = 0; mi < 2; ++mi)
#pragma unroll
            for (int rg = 0; rg < 4; ++rg) { const int t = 32 * wm + 16 * mi + 4 * fq + rg; const float inv = 1.f / fmaxf(fabsf(den[t]), 1.f);
#pragma unroll
                for (int ni = 0; ni < 4; ++ni) hsum[mi][ni][rg] += acc[mi][ni][rg] * inv; }
        __syncthreads();
    }
#pragma unroll
    for (int mi = 0; mi < 2; ++mi)
#pragma unroll
        for (int rg = 0; rg < 4; ++rg) { float s = 0.f;
#pragma unroll
            for (int ni = 0; ni < 4; ++ni) s += hsum[mi][ni][rg] * hsum[mi][ni][rg];
            s += __shfl_xor(s, 1); s += __shfl_xor(s, 2); s += __shfl_xor(s, 4); s += __shfl_xor(s, 8);
            if (fr == 0) part[(32 * wm + 16 * mi + 4 * fq + rg) * 2 + wn] = s; }
    __syncthreads();
#pragma unroll
    for (int mi = 0; mi < 2; ++mi)
#pragma unroll
        for (int rg = 0; rg < 4; ++rg) { const int t = 32 * wm + 16 * mi + 4 * fq + rg; const float rstd = rsqrtf((part[t * 2] + part[t * 2 + 1]) * (1.f / 128.f) + 1e-6f);
#pragma unroll
            for (int ni = 0; ni < 4; ++ni) { const int c = h * 128 + 64 * wn + 16 * ni + fr; const float o = bf2f(MLO[(size_t)(r0 + t) * 512 + c]);
                YM[(size_t)(r0 + t) * 512 + c] = (bf16_t)f2bf(hsum[mi][ni][rg] * rstd * g_norm[c] * sigmoidf_(o)); } }
    __syncthreads();
}
__device__ __forceinline__ void gqa_prep_item(int row, int hs, bf16_t* GQQ, bf16_t* GQK, const float* gq, const float* gk) {
    bf16_t* p = (hs < 8) ? GQQ + (size_t)row * 512 + hs * 64 : GQK + (size_t)row * 128 + (hs - 8) * 64; const float* g = (hs < 8) ? gq : gk;
    float x[64]; float ss = 0.f;
#pragma unroll
    for (int i = 0; i < 8; ++i) { const u32x4 v = *(const u32x4*)(p + 8 * i); x[8 * i] = bflo(v.x); x[8 * i + 1] = bfhi(v.x); x[8 * i + 2] = bflo(v.y); x[8 * i + 3] = bfhi(v.y); x[8 * i + 4] = bflo(v.z); x[8 * i + 5] = bfhi(v.z); x[8 * i + 6] = bflo(v.w); x[8 * i + 7] = bfhi(v.w); }
#pragma unroll
    for (int i = 0; i < 64; ++i) ss += x[i] * x[i];
    const float rstd = rsqrtf(ss * (1.f / 64.f) + 1e-6f);
#pragma unroll
    for (int i = 0; i < 64; ++i) x[i] = x[i] * rstd * g[i];
    const int b = row / SB, s = row - b * SB;
    if (s >= CTX) { const int n = s - CTX; const float pr = (float)(n >> 6), pc = (float)(n & 63);
#pragma unroll
        for (int i = 0; i < 16; ++i) { const float fr_ = exp2f(-(float)i * (13.287712379549449f / 16.f));
            float sn, cs; __sincosf(pr * fr_, &sn, &cs); const float a1 = x[i], a2 = x[16 + i]; x[i] = a1 * cs - a2 * sn; x[16 + i] = a1 * sn + a2 * cs;
            __sincosf(pc * fr_, &sn, &cs); const float b1 = x[32 + i], b2 = x[48 + i]; x[32 + i] = b1 * cs - b2 * sn; x[48 + i] = b1 * sn + b2 * cs; } }
    const float sc = (hs < 8) ? 0.125f * LOG2E : 1.f;
#pragma unroll
    for (int i = 0; i < 8; ++i) { u32x4 o; o.x = pk2(x[8 * i] * sc, x[8 * i + 1] * sc); o.y = pk2(x[8 * i + 2] * sc, x[8 * i + 3] * sc); o.z = pk2(x[8 * i + 4] * sc, x[8 * i + 5] * sc); o.w = pk2(x[8 * i + 6] * sc, x[8 * i + 7] * sc); *(u32x4*)(p + 8 * i) = o; }
}

struct RsLinear { __device__ __forceinline__ int operator()(int t) const { return 64 * t; } };
struct RsNa { int w0; __device__ __forceinline__ int operator()(int t) const { return t < 4 ? 64 * t : CTX + 64 * (w0 + t - 4); } };
struct NaHook { static constexpr bool ON = true; const LAS float* tab; int r0, w0;
    __device__ __forceinline__ void operator()(f32x16& C0, f32x16& C1, int t, int wid, int r32, int hi, float mhat) const {
        if (t < 4) {
#pragma unroll
            for (int q = 0; q < 16; ++q) { C0[q] -= mhat; C1[q] -= mhat; }
            return; }
        const int r = r0 + (wid >> 1), c = 32 * (wid & 1) + r32, kr = w0 + t - 4;
        const int rs = min(max(r - 4, 0), 120), cs = min(max(c - 8, 0), 48);
        const float NEG = -INFINITY;
        if (kr < rs || kr >= rs + 8) {
#pragma unroll
            for (int q = 0; q < 16; ++q) { C0[q] = NEG; C1[q] = NEG; }
            return; }
        const LAS float* tl = tab + (kr - r + 7) * 31 + (15 - c) + 4 * hi; const int kb = 4 * hi - cs;
#pragma unroll
        for (int q = 0; q < 16; ++q) { const int ko = (q & 3) + 8 * (q >> 2);
            C0[q] = ((unsigned)(kb + ko) < 16u) ? C0[q] + (tl[ko] - mhat) : NEG; C1[q] = ((unsigned)(kb + ko + 32) < 16u) ? C1[q] + (tl[ko + 32] - mhat) : NEG; }
    }
};
__device__ __forceinline__ void na_phase(int l, int vcu, int G, const float* rpb_l, unsigned char* ws, char* lds) {
    const bf16_t* NAQ = (const bf16_t*)(ws + WS_A + A_P512), *NAK = NAQ + (size_t)RT * 512, *NAV = NAK + (size_t)RT * 512; bf16_t* YB = (bf16_t*)(ws + WS_B + SZ512);
    float* tabf = (float*)(lds + NA_TAB_OFF);
    for (int i = otid(); i < 8 * 465; i += 512) tabf[i] = rpb_l[i] * LOG2E;
    __syncthreads();
    const int nu = 512 + (l == 0 ? 16 : 0);
    for (int u = vcu; u < nu; u += G) {
        using bf = attn_body::bf16;
        if (u < 512) { const int b = u >> 8, h = (u >> 5) & 7, qb = u & 31; const int r0 = 4 * qb, w0 = min(max(r0 - 4, 0), 116);
            const size_t qrow = (size_t)b * SB + CTX + 256 * qb, krow = (size_t)b * SB;
            NaHook hk{(const LAS float*)(tabf + h * 465), r0, w0};
            attn_body::attn_unit<8>((const bf*)(NAQ + qrow * 512 + h * 64), 512, (const bf*)(NAK + krow * 512 + h * 64), (const bf*)(NAV + krow * 512 + h * 64), 512, RsNa{w0}, 16, (bf*)(YB + qrow * 512 + h * 64), 512, lds, hk);
        } else { const int b = (u - 512) >> 3, h = (u - 512) & 7; const size_t krow = (size_t)b * SB;
            attn_body::attn_unit<8>((const bf*)(NAQ + krow * 512 + h * 64), 512, (const bf*)(NAK + krow * 512 + h * 64), (const bf*)(NAV + krow * 512 + h * 64), 512, RsLinear{}, 4, (bf*)(YB + krow * 512 + h * 64), 512, lds, attn_body::NoHook{});
        }
    }
}
__device__ __forceinline__ void gqa_phase(int l, int vcu, int G, unsigned char* ws, char* lds) {
    const bf16_t* GQQ = (const bf16_t*)(ws + WS_A + A_P512 + 7 * SZ512), *GQK = (const bf16_t*)(ws + WS_A + A_GQK), *GQV = (const bf16_t*)(ws + WS_A + A_GQV); bf16_t* YD = (bf16_t*)(ws + WS_B + 3 * SZ512);
    const int nu = 512 + (l == 0 ? 16 : 0);
    for (int u = vcu; u < nu; u += G) {
        using bf = attn_body::bf16;
        if (u < 512) { const int hq = u & 3, qb = (u >> 2) & 31, kvh = (u >> 7) & 1, b = u >> 8, h = kvh * 4 + hq;
            const size_t qrow = (size_t)b * SB + CTX + 256 * qb, krow = (size_t)b * SB;
            attn_body::attn_unit<8>((const bf*)(GQQ + qrow * 512 + h * 64), 512, (const bf*)(GQK + krow * 128 + kvh * 64), (const bf*)(GQV + krow * 128 + kvh * 64), 128, RsLinear{}, SB / 64, (bf*)(YD + qrow * 512 + h * 64), 512, lds, attn_body::NoHook{});
        } else { const int b = (u - 512) >> 3, h = (u - 512) & 7, kvh = h >> 2; const size_t krow = (size_t)b * SB;
            attn_body::attn_unit<8>((const bf*)(GQQ + krow * 512 + h * 64), 512, (const bf*)(GQK + krow * 128 + kvh * 64), (const bf*)(GQV + krow * 128 + kvh * 64), 128, RsLinear{}, 4, (bf*)(YD + krow * 512 + h * 64), 512, lds, attn_body::NoHook{});
        }
    }
}

__device__ __forceinline__ int s5_order(int d, int s) { if (d == 0) return s; return s < 8 ? 7 - s : 271 - s; }
__device__ __forceinline__ void s5_scan(const float* SST, const float* AL, bf16_t* UH, int gtid, int nthreads) {
    for (int q = gtid; q < 2 * 2 * 32 * 64; q += nthreads) {
        const int p = q & 63, g = (q >> 6) & 31, d = (q >> 11) & 1, b = q >> 12;
        const float ar = AL[((d * 32 + g) * 64 + p) * 2], ai = AL[((d * 32 + g) * 64 + p) * 2 + 1]; float hr = 0.f, hi_ = 0.f;
        const float* sp = SST + ((size_t)g * S5ROWS + b * S5NC) * 256 + d * 128 + 2 * p; bf16_t* up = UH + ((size_t)g * S5RP + b * S5NC) * 768 + 512 + d * 128 + 2 * p;
        for (int s = 0; s < S5NC; s += 8) { f32x2 x[8];
#pragma unroll
            for (int k = 0; k < 8; ++k) x[k] = *(const f32x2*)(sp + (size_t)s5_order(d, s + k) * 256);
#pragma unroll
            for (int k = 0; k < 8; ++k) { const int cc = s5_order(d, s + k); *(unsigned*)(up + (size_t)cc * 768) = pk2(hr, hi_);
                const float nr = ar * hr - ai * hi_ + x[k].x, ni = ar * hi_ + ai * hr + x[k].y; hr = nr; hi_ = ni; } }
    }
}

__device__ __forceinline__ void route_token(const float (&lg)[32], const float* b_router, int& e0, int& e1, float& w0, float& w1) {
    float s[32], sel[32];
#pragma unroll
    for (int i = 0; i < 32; ++i) { s[i] = sigmoidf_(lg[i]); sel[i] = s[i] + b_router[i]; }
    float best = -INFINITY; int grp = 0;
#pragma unroll
    for (int gi = 0; gi < 8; ++gi) { const float a = sel[4 * gi], b = sel[4 * gi + 1], c = sel[4 * gi + 2], d = sel[4 * gi + 3];
        const float m1 = fmaxf(fmaxf(a, b), fmaxf(c, d)); const float sum = a + b + c + d, mn = fminf(fminf(a, b), fminf(c, d));
        float x0 = a, x1 = b, x2 = c, x3 = d; bool rem = false; float sec = -INFINITY;
        if (!rem && x0 == m1) rem = true; else sec = fmaxf(sec, x0);
        if (!rem && x1 == m1) rem = true; else sec = fmaxf(sec, x1);
        if (!rem && x2 == m1) rem = true; else sec = fmaxf(sec, x2);
        if (!rem && x3 == m1) rem = true; else sec = fmaxf(sec, x3);
        (void)sum; (void)mn;
        const float sc = m1 + sec; if (sc > best) { best = sc; grp = gi; } }
    float v[4]; float sv[4];
#pragma unroll
    for (int j = 0; j < 4; ++j) { v[j] = 0.f; sv[j] = 0.f; }
#pragma unroll
    for (int gi = 0; gi < 8; ++gi) if (gi == grp) {
#pragma unroll
        for (int j = 0; j < 4; ++j) { v[j] = sel[4 * gi + j]; sv[j] = s[4 * gi + j]; } }
    int i0 = 0; float m = v[0];
#pragma unroll
    for (int j = 1; j < 4; ++j) if (v[j] > m) { m = v[j]; i0 = j; }
    int i1 = -1; float m2 = -INFINITY;
#pragma unroll
    for (int j = 0; j < 4; ++j) if (j != i0 && v[j] > m2) { m2 = v[j]; i1 = j; }
    float s0 = 0.f, s1 = 0.f;
#pragma unroll
    for (int j = 0; j < 4; ++j) { if (j == i0) s0 = sv[j]; if (j == i1) s1 = sv[j]; }
    e0 = grp * 4 + i0; e1 = grp * 4 + i1; const float inv = 1.f / (s0 + s1); w0 = s0 * inv; w1 = s1 * inv;
}
__device__ __forceinline__ int moe_offsets(const unsigned* cnt, LAS int* offs, LAS int* texp) {
    if (otid() == 0) { int o = 0; for (int e = 0; e < 32; ++e) { offs[e] = o; const int c = (int)__hip_atomic_load(cnt + e, __ATOMIC_RELAXED, __HIP_MEMORY_SCOPE_AGENT); const int pt = (c + 255) >> 8; for (int t = 0; t < pt; ++t) texp[(o >> 8) + t] = e; o += pt * 256; } offs[32] = o; }
    __syncthreads();
    return offs[32] >> 8;
}
#ifndef MK_MULTI
#define MK_MULTI 0
#endif
constexpr int NPHASE = 26;
#ifndef PHMASK
#define PHMASK 0xffff
#endif
#define HAS(k) (((PHMASK) >> (k)) & 1)
#ifndef SUBMASK
#define SUBMASK 0xff
#endif
#define SUB(k) (((SUBMASK) >> (k)) & 1)
struct Args { const float* in[34]; float* out; unsigned char* ws; int ph_lo, ph_hi; };
enum { I_X = 0, I_C, I_CTX, I_CCTX, I_WMOD, I_BMOD, I_GN1, I_GN2, I_WIN, I_LAMRE, I_LAMIM, I_LOGDT, I_BRE, I_BIM, I_CRE, I_CIM, I_S5D, I_WGLU, I_BGLU, I_RPB, I_MLBG, I_MLNORM, I_GQQN, I_GQKN,
       I_WBR, I_WGATE, I_BGATE, I_WOUT, I_WROUTER, I_BROUTER, I_W1, I_W3, I_W2, I_GFINAL };

__device__ __forceinline__ void norm_mod_vals(f32x4 (&v)[4], const float* g, const float* shift, const float* scale, bf16_t* orow, int lane) {
    float s = 0.f;
#pragma unroll
    for (int j = 0; j < 4; ++j) s += (v[j].x * v[j].x + v[j].y * v[j].y) + (v[j].z * v[j].z + v[j].w * v[j].w);
    const float rstd = rsqrtf(wave_sum(s) * (1.f / DM) + 1e-6f);
#pragma unroll
    for (int j = 0; j < 4; ++j) { const f32x4 gg = ((const f32x4*)g)[lane + 64 * j], sh = ((const f32x4*)shift)[lane + 64 * j], sc = ((const f32x4*)scale)[lane + 64 * j];
        v[j] = (v[j] * rstd * gg) * (sc + 1.f) + sh;
        u32x2 o; o.x = pk2(v[j].x, v[j].y); o.y = pk2(v[j].z, v[j].w); ((u32x2*)orow)[lane + 64 * j] = o; }
}

__device__ __forceinline__ const char* kseg() { const char* ka = (const char*)__builtin_amdgcn_kernarg_segment_ptr(); asm volatile("" : "+s"(ka)); return ka; }
__device__ __forceinline__ const float* kin(int i) { return *(const float* const*)(kseg() + 8 * i); }
__device__ __forceinline__ float* kout() { return *(float* const*)(kseg() + 8 * 34); }
__device__ __forceinline__ unsigned char* kws() { return *(unsigned char* const*)(kseg() + 8 * 35); }
template <int K, int L>
__device__ __forceinline__ void run_phase(unsigned char* ws, float* out, const int vcu, const int G, const int bx, LAS unsigned char* lds, unsigned char* lds_raw) {
    const int NGW = G * 8, NTH = G * 512;
    float* xctx = (float*)(ws + WS_XCTX); unsigned* ctl = (unsigned*)(ws + WS_CTL);
    float* MODV = (float*)(ws + WS_MODV); bf16_t* HB = (bf16_t*)(ws + WS_HB);
    unsigned char* RA = ws + WS_A; unsigned char* RB = ws + WS_B; unsigned char* RC = ws + WS_C;
    LAS int* offs = (LAS int*)(lds + MISC_OFF + 64); LAS int* texp = (LAS int*)(lds + MISC_OFF + 256);
    int* TOK_E = (int*)(ws + WS_ROUTE); float* TOK_W = (float*)(ws + WS_ROUTE + (size_t)RT * 8); int* TOK_DST = (int*)(ws + WS_ROUTE + (size_t)RT * 16);
    {
        const int tid = otid(), lane = tid & 63, wave = __builtin_amdgcn_readfirstlane(tid >> 6), gw = vcu * 8 + wave, gtid = vcu * 512 + tid;
        constexpr int l = L, k = K; constexpr bool last = (l == 1);
        const float* modl = MODV + l * 3 * 6144;
        if constexpr (HAS(0) && (k == 0 || (k == 13 && l == 0))) {
            const int lc = (k == 0) ? 0 : 1;
            if (k == 0) {
                const f32x4* x4 = (const f32x4*)kin(I_X); f32x4* o4 = (f32x4*)out;
                for (int i = gtid; i < NB * SEQ * DM / 4; i += NTH) o4[i] = x4[i];
                const f32x4* c4 = (const f32x4*)kin(I_CTX); f32x4* xc4 = (f32x4*)xctx;
                for (int i = gtid; i < NB * CTX * DM / 4; i += NTH) xc4[i] = c4[i];
            } else {
                const bf16_t* MY = (const bf16_t*)(RA + A_MY);
                for (int row = gw; row < RT; row += NGW) {
                    float* xr = xrow_ptr(out, xctx, row); const int ms = modsel(row); const float* m5 = modl + ms * 6144 + 5 * 1024;
                    const int d0 = TOK_DST[row * 2], d1 = TOK_DST[row * 2 + 1]; const float w0 = TOK_W[row * 2], w1 = TOK_W[row * 2 + 1];
                    f32x4 v[4];
#pragma unroll
                    for (int j = 0; j < 4; ++j) { const u32x2 y0 = ((const u32x2*)(MY + (size_t)d0 * 1024))[lane + 64 * j], y1 = ((const u32x2*)(MY + (size_t)d1 * 1024))[lane + 64 * j];
                        const f32x4 f = (f32x4){w0 * bflo(y0.x) + w1 * bflo(y1.x), w0 * bfhi(y0.x) + w1 * bfhi(y1.x), w0 * bflo(y0.y) + w1 * bflo(y1.y), w0 * bfhi(y0.y) + w1 * bfhi(y1.y)};
                        v[j] = ((const f32x4*)xr)[lane + 64 * j] + ((const f32x4*)m5)[lane + 64 * j] * f; ((f32x4*)xr)[lane + 64 * j] = v[j]; }
                    const float* mn = MODV + 3 * 6144 + ms * 6144;
                    norm_mod_vals(v, kin(I_GN1) + DM, mn, mn + 1024, HB + (size_t)row * DM, lane);
                }
            }
            const bool split = (G >= 64);
            if (!split || vcu < 32) {
                for (int g = vcu; g < 32; g += (split ? 32 : G))
                    s5_precompute(lc, g, kin(I_LAMRE), kin(I_LAMIM), kin(I_LOGDT), kin(I_BRE), kin(I_BIM), kin(I_CRE), kin(I_CIM), kin(I_S5D), ws, lds);
                if (k == 0) {
                    LAS float* scs = (LAS float*)lds;
                    for (int i = tid; i < 3072; i += 512) { const float cv = (i < 2048) ? kin(I_C)[i] : kin(I_CCTX)[i - 2048]; scs[i] = cv * sigmoidf_(cv); }
                    __syncthreads();
                    const int nwv = split ? 256 : NGW;
                    for (int it = gw; it < 192; it += nwv) modv_item(it, kin(I_WMOD), kin(I_BMOD), MODV, scs, lane);
                    __syncthreads();
                }
            }
            if (!split || vcu >= 32) {
                const int gwc = split ? gw - 256 : gw, ngc = split ? NGW - 256 : NGW;
                conv_layer_weights(kin(I_WIN) + (size_t)lc * 1024 * 4880, kin(I_WGATE) + (size_t)lc * 1024 * 4096, kin(I_WBR) + (size_t)lc * 4 * 512 * 1024, kin(I_WOUT) + (size_t)lc * 1024 * 1024,
                                   kin(I_WGLU) + (size_t)lc * 512 * 512, ws, (LAS float*)(lds + wave * 8448), gwc, ngc, lane);
            }
        } else if constexpr (HAS(1) && k == 1) {
            for (int row = gw; row < RT; row += NGW) { const float* mn = MODV + modsel(row) * 6144; f32x4 v[4];
                norm_mod_row(xrow_ptr(out, xctx, row), kin(I_GN1), mn, mn + 1024, HB + (size_t)row * DM, lane, v); }
        } else if constexpr (HAS(2) && k == 2) {
            pg8::Gemm g{HB, (const bf16_t*)(ws + WS_WG1), 1024, 1024, 1024}; GridOrder S; S.init(NTILE, 36, G, bx, 0);
            EpiG1 E{ws, kin(I_MLBG) + l * 16, kin(I_BGATE) + l * 4096};
            pg8::gemm_phase(lds, g, S, E);
        } else if constexpr (HAS(3) && k == 3) {
            if (SUB(0)) { pg8::Gemm g{(const bf16_t*)(RA + A_UH), (const bf16_t*)(ws + WS_S5BS), 768, 512, 512}; S5Order<1> S{G, vcu}; EpiS5State E{(float*)(RC + C_SST)}; pg8::gemm_phase(lds, g, S, E); }
            if (SUB(1)) { const bf16_t* MLK = (const bf16_t*)(RA + A_P512 + 4 * SZ512), *MLV = (const bf16_t*)(RA + A_P512 + 5 * SZ512);
              for (int it = G - 1 - vcu; it < 1056; it += G) { const int cc = it % MLNC, h = (it / MLNC) & 3, d = (it / (MLNC * 4)) & 1, b = it / (MLNC * 8);
                  ml_stage_a(b, h, cc, d, MLK, MLV, (const float*)(RA + A_MLG), (bf16_t*)(RC + C_CST), (float*)(RC + C_NST), (float*)(RC + C_DEC), lds); } }
            if (SUB(2)) { bf16_t* GQQ = (bf16_t*)(RA + A_P512 + 7 * SZ512); bf16_t* GQK = (bf16_t*)(RA + A_GQK);
              for (int q = gtid; q < RT * 10; q += NTH) gqa_prep_item(q / 10, q % 10, GQQ, GQK, kin(I_GQQN) + l * 64, kin(I_GQKN) + l * 64); }
            __syncthreads();
            if (SUB(3)) na_phase(l, vcu, G, kin(I_RPB) + l * 3720, ws, (char*)lds_raw);
        } else if constexpr (HAS(4) && k == 4) {
            s5_scan((const float*)(RC + C_SST), (const float*)(ws + WS_S5AL), (bf16_t*)(RA + A_UH), gtid, NTH);
            ml_scan((bf16_t*)(RC + C_CST), (float*)(RC + C_NST), (const float*)(RC + C_DEC), gtid, NTH);
            gqa_phase(l, vcu, G, ws, (char*)lds_raw);
        } else if constexpr (HAS(5) && k == 5) {
            pg8::Gemm g{(const bf16_t*)(RA + A_UH), (const bf16_t*)(ws + WS_S5BO), 768, 768, 768}; S5Order<2> S{G, vcu}; EpiS5Out E{(bf16_t*)(RB + B_Z)}; pg8::gemm_phase(lds, g, S, E);
        } else if constexpr (HAS(6) && k == 6) {
            if (SUB(0)) { pg8::Gemm g{(const bf16_t*)(RB + B_Z), (const bf16_t*)(ws + WS_WGLU), 512, 512, 512}; GridOrder S; S.init(last ? 64 : NTILE, 2, G, bx, last ? 1 : 0);
              EpiGlu E{(const bf16_t*)(RB + B_Z), (bf16_t*)RB, kin(I_BGLU) + l * 512}; pg8::gemm_phase(lds, g, S, E); }
            if (SUB(1)) { const bf16_t* P = (const bf16_t*)(RA + A_P512); const int ncc = last ? 64 : 66, nit = NB * 4 * ncc;
              for (int it = G - 1 - vcu; it < nit; it += G) { const int cc = it % ncc + (last ? 2 : 0), h = (it / ncc) & 3, b = it / (ncc * 4);
                  ml_stage_c(b, h, cc, P + 3 * (size_t)RT * 512, P + 4 * (size_t)RT * 512, P + 5 * (size_t)RT * 512, P + 6 * (size_t)RT * 512, (const float*)(RA + A_MLG), (const bf16_t*)(RC + C_CST), (const float*)(RC + C_NST),
                             kin(I_MLNORM) + l * 512, (bf16_t*)(RB + 2 * SZ512), lds); } }
        } else if constexpr (HAS(7) && k == 7) {
            pg8::Gemm g{(const bf16_t*)RB, (const bf16_t*)(ws + WS_WBR), 512, 512, 512}; QuadOrder S; S.init(last ? 64 : NTILE, 4, G, bx, last ? 1 : 0);
            EpiMerge E{(const bf16_t*)(RA + A_GATE), (float*)(RA + A_MSUM), HB}; pg8::gemm_phase(lds, g, S, E);
        } else if constexpr (HAS(8) && k == 8) {
            { pg8::Gemm g{HB, (const bf16_t*)(ws + WS_WOUT), 1024, 1024, 1024}; GridOrder S; S.init(last ? 64 : NTILE, 4, G, bx, last ? 1 : 0);
              EpiWout E{out, xctx, modl}; pg8::gemm_phase(lds, g, S, E); }
            conv_moe_weights(kin(I_W1) + (size_t)l * 32 * 1024 * 512, kin(I_W3) + (size_t)l * 32 * 1024 * 512, kin(I_W2) + (size_t)l * 32 * 512 * 1024, ws, (LAS float*)(lds + wave * 8448), gw, NGW, lane);
        } else if constexpr (HAS(9) && k == 9) {
            LAS float* wl = (LAS float*)lds;
            for (int i = tid; i < 1024 * 32; i += 512) { const int kk = i >> 5, e = i & 31; wl[((kk & 3) * 256 + (kk >> 2)) * 36 + e] = kin(I_WROUTER)[i]; }
            __syncthreads();
            unsigned* cnt = ctl + CW_CNT + 64 * l;
            for (int row = gw; row < RT; row += NGW) {
                const int ms = modsel(row); if (last && ms == 2) continue;
                const float* mn = modl + ms * 6144; f32x4 v[4];
                norm_mod_row(xrow_ptr(out, xctx, row), kin(I_GN2) + l * DM, mn + 3 * 1024, mn + 4 * 1024, HB + (size_t)row * DM, lane, v);
                float lg[32];
#pragma unroll
                for (int i = 0; i < 32; ++i) lg[i] = 0.f;
#pragma unroll
                for (int j = 0; j < 4; ++j)
#pragma unroll
                    for (int e = 0; e < 4; ++e) { const float hv = v[j][e]; const LAS f32x4* wp = (const LAS f32x4*)(wl + (e * 256 + lane + 64 * j) * 36);
#pragma unroll
                        for (int q = 0; q < 8; ++q) { const f32x4 w = wp[q]; lg[4 * q] += hv * w.x; lg[4 * q + 1] += hv * w.y; lg[4 * q + 2] += hv * w.z; lg[4 * q + 3] += hv * w.w; } }
#pragma unroll
                for (int i = 0; i < 32; ++i) lg[i] = wave_sum(lg[i]);
                int e0, e1; float w0, w1; route_token(lg, kin(I_BROUTER), e0, e1, w0, w1);
                if (lane == 0) { const int p0 = (int)atomicAdd(cnt + e0, 1u), p1 = (int)atomicAdd(cnt + e1, 1u);
                    TOK_E[row * 2] = e0; TOK_E[row * 2 + 1] = e1; TOK_W[row * 2] = w0; TOK_W[row * 2 + 1] = w1; TOK_DST[row * 2] = p0; TOK_DST[row * 2 + 1] = p1; }
            }
            __syncthreads();
        } else if constexpr (HAS(10) && k == 10) {
            (void)moe_offsets(ctl + CW_CNT + 64 * l, offs, texp);
            bf16_t* MBUF = (bf16_t*)(RA + A_MBUF);
            for (int row = gw; row < RT; row += NGW) {
                if (last && modsel(row) == 2) continue;
                const int d0 = offs[TOK_E[row * 2]] + TOK_DST[row * 2], d1 = offs[TOK_E[row * 2 + 1]] + TOK_DST[row * 2 + 1];
                const u32x4 v0 = ((const u32x4*)(HB + (size_t)row * DM))[lane], v1 = ((const u32x4*)(HB + (size_t)row * DM))[lane + 64];
                ((u32x4*)(MBUF + (size_t)d0 * DM))[lane] = v0; ((u32x4*)(MBUF + (size_t)d0 * DM))[lane + 64] = v1;
                ((u32x4*)(MBUF + (size_t)d1 * DM))[lane] = v0; ((u32x4*)(MBUF + (size_t)d1 * DM))[lane + 64] = v1;
                if (lane == 0) { TOK_DST[row * 2] = d0; TOK_DST[row * 2 + 1] = d1; }
            }
            __syncthreads();
        } else if constexpr (HAS(11) && k == 11) {
            const int nt = moe_offsets(ctl + CW_CNT + 64 * l, offs, texp);
            pg8::Gemm g{(const bf16_t*)(RA + A_MBUF), (const bf16_t*)(RA + A_W13), 1024, 1024, 1024}; MoeOrder S{G, vcu, nt, texp}; EpiMoe1 E{(bf16_t*)(RA + A_MH)}; pg8::gemm_phase(lds, g, S, E);
        } else if constexpr (HAS(12) && k == 12) {
            const int nt = moe_offsets(ctl + CW_CNT + 64 * l, offs, texp);
            pg8::Gemm g{(const bf16_t*)(RA + A_MH), (const bf16_t*)(RA + A_W2), 512, 512, 512}; MoeOrder S{G, vcu, nt, texp}; EpiMoe2 E{(bf16_t*)(RA + A_MY)}; pg8::gemm_phase(lds, g, S, E);
        } else if constexpr (HAS(13) && k == 13) {
            const bf16_t* MY = (const bf16_t*)(RA + A_MY);
            for (int row = gw; row < RT; row += NGW) {
                const int ms = modsel(row); if (ms == 2) continue;
                float* xr = xrow_ptr(out, xctx, row); const float* m5 = modl + ms * 6144 + 5 * 1024;
                const int d0 = TOK_DST[row * 2], d1 = TOK_DST[row * 2 + 1]; const float w0 = TOK_W[row * 2], w1 = TOK_W[row * 2 + 1];
                f32x4 v[4]; float s = 0.f;
#pragma unroll
                for (int j = 0; j < 4; ++j) { const u32x2 y0 = ((const u32x2*)(MY + (size_t)d0 * 1024))[lane + 64 * j], y1 = ((const u32x2*)(MY + (size_t)d1 * 1024))[lane + 64 * j];
                    const f32x4 f = (f32x4){w0 * bflo(y0.x) + w1 * bflo(y1.x), w0 * bfhi(y0.x) + w1 * bfhi(y1.x), w0 * bflo(y0.y) + w1 * bflo(y1.y), w0 * bfhi(y0.y) + w1 * bfhi(y1.y)};
                    v[j] = ((const f32x4*)xr)[lane + 64 * j] + ((const f32x4*)m5)[lane + 64 * j] * f; s += (v[j].x * v[j].x + v[j].y * v[j].y) + (v[j].z * v[j].z + v[j].w * v[j].w); }
                const float rstd = rsqrtf(wave_sum(s) * (1.f / DM) + 1e-6f);
#pragma unroll
                for (int j = 0; j < 4; ++j) ((f32x4*)xr)[lane + 64 * j] = v[j] * rstd * ((const f32x4*)kin(I_GFINAL))[lane + 64 * j];
            }
        }
    }
}

__global__ void __launch_bounds__(512, 2) hybrid_fwd(Args a) {
    LAS unsigned char* lds = (LAS unsigned char*)lds_raw;
    { const int t0 = threadIdx.x; if ((t0 & 63) == 0) ((volatile LAS int*)(lds + WMAP_OFF))[(unsigned)__builtin_amdgcn_s_getreg((5 << 11) | 4) & 63u] = t0 >> 6; }
    __syncthreads();
    const int tid0 = otid();
    const int G = gridDim.x, bx = blockIdx.x, vcu = (G % 8 == 0) ? (bx % 8) * (G / 8) + bx / 8 : bx;
    volatile LAS unsigned* MISC = (volatile LAS unsigned*)(lds + MISC_OFF);
    if (tid0 < 16) MISC[tid0] = 0u;
    __syncthreads();
    const int lo = a.ph_lo, hi = a.ph_hi;
    XcdBarrier bar; bar.bar = (unsigned*)(a.ws + WS_CTL) + CW_BAR; bar.x = 0; bar.st = MISC;
    if (hi - lo > 1) bar = xcd_barrier_post((unsigned*)(a.ws + WS_CTL) + CW_BAR, MISC);
#define SEAM(ph) do { if ((ph) + 1 < hi) { if constexpr ((ph) == 0) { __threadfence(); cg::this_grid().sync(); __builtin_amdgcn_fence(__ATOMIC_ACQUIRE, "agent"); asm volatile("s_waitcnt vmcnt(0)" ::: "memory"); __syncthreads(); } else xcd_barrier(bar); } } while (0)
#define PH(ph, K, L) do { if (lo <= (ph) && (ph) < hi) { run_phase<K, L>(a.ws, a.out, vcu, G, bx, lds, lds_raw); SEAM(ph); } } while (0)
    PH(0, 0, 0); PH(1, 1, 0);
    PH(2, 2, 0); PH(3, 3, 0); PH(4, 4, 0); PH(5, 5, 0); PH(6, 6, 0); PH(7, 7, 0); PH(8, 8, 0); PH(9, 9, 0); PH(10, 10, 0); PH(11, 11, 0); PH(12, 12, 0); PH(13, 13, 0);
    PH(14, 2, 1); PH(15, 3, 1); PH(16, 4, 1); PH(17, 5, 1); PH(18, 6, 1); PH(19, 7, 1); PH(20, 8, 1); PH(21, 9, 1); PH(22, 10, 1); PH(23, 11, 1); PH(24, 12, 1); PH(25, 13, 1);
#undef PH
#undef SEAM
}

extern "C" void kernel_launch(void* const* d_in, const int* in_sizes, int n_in, void* d_out, int out_size, void* d_ws, size_t ws_size, hipStream_t stream) {
    static int grid = 0;
    if (grid == 0) {
        if (n_in != 34 || out_size != NB * SEQ * DM || ws_size < WS_END) { fprintf(stderr, "kernel_launch: unexpected problem (n_in %d out %d ws %zu, need ws >= %zu)\n", n_in, out_size, ws_size, (size_t)WS_END); grid = -1; return; }
        int dev = 0, cus = 0, per_cu = 0;
        hipGetDevice(&dev); hipDeviceGetAttribute(&cus, hipDeviceAttributeMultiprocessorCount, dev);
        if (hipFuncSetAttribute((const void*)hybrid_fwd, hipFuncAttributeMaxDynamicSharedMemorySize, LDS_BYTES) != hipSuccess) { fprintf(stderr, "kernel_launch: hipFuncSetAttribute failed\n"); grid = -1; return; }
        if (hipOccupancyMaxActiveBlocksPerMultiprocessor(&per_cu, (const void*)hybrid_fwd, 512, LDS_BYTES) != hipSuccess || per_cu < 1) { fprintf(stderr, "kernel_launch: occupancy query says %d blocks per CU\n", per_cu); grid = -1; return; }
        (void)hipGetLastError();
        grid = cus;
    }
    if (grid < 0) return;
    hipMemsetAsync((char*)d_ws + WS_CTL, 0, CTL_BYTES, stream);
    Args a{};
    for (int i = 0; i < 34; ++i) a.in[i] = (const float*)d_in[i];
    a.out = (float*)d_out; a.ws = (unsigned char*)d_ws;
#if MK_MULTI
    for (int ph = 0; ph < NPHASE; ++ph) { a.ph_lo = ph; a.ph_hi = ph + 1; void* args[] = {&a};
        hipError_t e = hipLaunchCooperativeKernel((const void*)hybrid_fwd, dim3(grid), dim3(512), args, LDS_BYTES, stream);
        if (e != hipSuccess) { fprintf(stderr, "launch %d failed: %s\n", ph, hipGetErrorString(e)); break; } }
#else
    a.ph_lo = 0; a.ph_hi = NPHASE; void* args[] = {&a};
    hipError_t e = hipLaunchCooperativeKernel((const void*)hybrid_fwd, dim3(grid), dim3(512), args, LDS_BYTES, stream);
    if (e != hipSuccess) fprintf(stderr, "cooperative launch failed: %s (grid %d)\n", hipGetErrorString(e), grid);
#endif
}
```

```cpp
#include <hip/hip_runtime.h>
#include <hip/hip_bf16.h>
#include <hip/hip_cooperative_groups.h>
#include <cstdio>
#include <cstdint>
#include <cmath>
namespace cg = cooperative_groups;

#define LAS __attribute__((address_space(3)))
#define GAS __attribute__((address_space(1)))
typedef unsigned short bf16_t;
typedef short bf16x8 __attribute__((ext_vector_type(8)));
typedef short s16x4 __attribute__((ext_vector_type(4)));
typedef float f32x2 __attribute__((ext_vector_type(2)));
typedef float f32x4 __attribute__((ext_vector_type(4)));
typedef float f32x16 __attribute__((ext_vector_type(16)));
typedef unsigned u32x2 __attribute__((ext_vector_type(2)));
typedef unsigned u32x4 __attribute__((ext_vector_type(4)));

constexpr int DM = 1024, NB = 2, SEQ = 8192, CTX = 256, SB = SEQ + CTX  , RT = NB * SB  ;
constexpr int BW = 512, NTILE = RT / 256  , TPB = SB / 256  ;
constexpr int NMOD = 6;
constexpr int S5L = 32  , S5NC = SB / S5L  , S5ROWS = NB * S5NC  , S5RP = 768  ;
constexpr int MLC = 128, MLNC = SB / MLC  ;
constexpr int NEXP = 32, MOE_MAXROWS = RT * 2 + NEXP * 256  , MOE_MAXT = MOE_MAXROWS / 256  ;
constexpr float LOG2E = 1.4426950408889634f;

extern __shared__ __attribute__((aligned(16))) unsigned char lds_raw[];
constexpr int LDS_BYTES = 155648, MISC_OFF = 151552, WMAP_OFF = MISC_OFF + 1024;
__device__ __forceinline__ int otid() {
    const unsigned hw = (unsigned)__builtin_amdgcn_s_getreg((5 << 11) | 4) & 63u;
    const int w = ((const volatile LAS int*)((LAS unsigned char*)lds_raw + WMAP_OFF))[hw];
    int t = w * 64 + (int)__builtin_amdgcn_mbcnt_hi(~0u, __builtin_amdgcn_mbcnt_lo(~0u, 0u)); asm volatile("" : "+v"(t)); return t; }
__device__ __forceinline__ unsigned f2bf(float f) { unsigned u = __builtin_bit_cast(unsigned, f); return (u + 0x7fffu + ((u >> 16) & 1u)) >> 16; }
__device__ __forceinline__ unsigned pk2(float lo, float hi) { return f2bf(lo) | (f2bf(hi) << 16); }
__device__ __forceinline__ float bf2f(unsigned short b) { return __builtin_bit_cast(float, ((unsigned)b) << 16); }
__device__ __forceinline__ float bflo(unsigned w) { return __builtin_bit_cast(float, w << 16); }
__device__ __forceinline__ float bfhi(unsigned w) { return __builtin_bit_cast(float, w & 0xffff0000u); }
__device__ __forceinline__ float wave_sum(float v) {
#pragma unroll
    for (int o = 1; o < 64; o <<= 1) v += __shfl_xor(v, o);
    return v;
}
__device__ __forceinline__ float sigmoidf_(float x) { return 1.f / (1.f + __expf(-x)); }
__device__ __forceinline__ float log_sigmoidf_(float x) { return fminf(x, 0.f) - log1pf(__expf(-fabsf(x))); }
__device__ __forceinline__ float gelu_tanh(float x) { const float u = 0.7978845608028654f * (x + 0.044715f * x * x * x); return x * sigmoidf_(2.f * u); }

namespace pg8 {
constexpr int BM = 256, BK = 64, HALF = 128, HTB = HALF * BK * 2, STAGE_BYTES = 8 * HTB;
__host__ __device__ __forceinline__ int lds_byte(int r, int c) { const int st = (r >> 4) * 2 + (c >> 5), rr = r & 15, cc = c & 31, ob = rr * 64 + cc * 2; return st * 1024 + (ob ^ (((ob >> 9) & 1) << 5)); }
__host__ __device__ __forceinline__ void stage_rc(int b, int& R, int& C) { const int st = b / 1024, sb = b % 1024, swz = sb ^ (((sb >> 9) & 1) << 5); R = (st >> 1) * 16 + swz / 64; C = (st & 1) * 32 + (swz % 64) / 2; }
__host__ __device__ __forceinline__ int perm32(int rho) { const int n = rho >> 4, i = rho & 15; return 8 * (i >> 2) + 4 * n + (i & 3); }
struct Unit { int pm, pn, z, pad; long aoff, boff; };
struct Gemm { const bf16_t* A; const bf16_t* Bt; int lda, ldb, K; };
__device__ __forceinline__ unsigned cvt_pk_bf16(float lo, float hi) { unsigned r; asm volatile("v_cvt_pk_bf16_f32 %0, %1, %2" : "=v"(r) : "v"(lo), "v"(hi)); return r; }

template <class Epi, class Sched>
__device__ __forceinline__ void gemm_phase(LAS unsigned char* lds, const Gemm g, const Sched& S, const Epi& E) {
    const int tid = otid(), wid = __builtin_amdgcn_readfirstlane(tid >> 6), lane = tid & 63, wr = wid >> 2, wc = wid & 3, fr = lane & 15, fq = lane >> 4;
    const int K = g.K, nt = K / BK;
    unsigned voffA[2], voffB[2];
#pragma unroll
    for (int i = 0; i < 2; ++i) { int R, C; stage_rc(tid * 16 + i * 8192, R, C); const int Rb = (R & ~31) + perm32(R & 31);
        voffA[i] = (unsigned)(R * g.lda + C) * 2u; voffB[i] = (unsigned)(Rb * g.ldb + C) * 2u; }
    const size_t kstep = (size_t)(BK * 2);
    const size_t hstepA = (size_t)HALF * g.lda * 2, hstepB = (size_t)HALF * g.ldb * 2;
    const size_t tstepA = 2 * hstepA, tstepB = 2 * hstepB;
    const unsigned ldsw = (unsigned)wid * 1024u;
    const int aoff = lds_byte(wr * 64 + fr, fq * 8), boff = lds_byte(wc * 32 + fr, fq * 8);
#define PG8_SA(b, h) (((b) * 2 + (h)) * HTB)
#define PG8_SB(b, h) ((4 + (b) * 2 + (h)) * HTB)
#define PG8_STAGE(bufoff, gbase, voff) do { _Pragma("unroll") for (int _i = 0; _i < 2; ++_i) \
        __builtin_amdgcn_global_load_lds((const GAS unsigned*)((const char*)(gbase) + (voff)[_i]), (LAS unsigned*)(lds + (bufoff) + ldsw + _i * 8192), 16, 0, 0); } while (0)
#define PG8_LDA(dst, b, h) do { _Pragma("unroll") for (int m = 0; m < 4; ++m) _Pragma("unroll") for (int k = 0; k < 2; ++k) dst[m][k] = *(const LAS bf16x8*)(lds + PG8_SA(b, h) + aoff + m * 2048 + k * 1024); } while (0)
#define PG8_LDB(dst, b, h) do { _Pragma("unroll") for (int n = 0; n < 2; ++n) _Pragma("unroll") for (int k = 0; k < 2; ++k) dst[n][k] = *(const LAS bf16x8*)(lds + PG8_SB(b, h) + boff + n * 2048 + k * 1024); } while (0)
#define PG8_MMA(ai, bj, At, Bt) do { __builtin_amdgcn_s_setprio(1); _Pragma("unroll") for (int m = 0; m < 4; ++m) _Pragma("unroll") for (int n = 0; n < 2; ++n) _Pragma("unroll") for (int k = 0; k < 2; ++k) \
        acc[ai][bj][m][n] = __builtin_amdgcn_mfma_f32_16x16x32_bf16(Bt[n][k], At[m][k], acc[ai][bj][m][n], 0, 0, 0); __builtin_amdgcn_s_setprio(0); } while (0)
#define PG8_WAIT_V(n) asm volatile("s_waitcnt vmcnt(" #n ")" ::: "memory")
#define PG8_WAIT_L(n) asm volatile("s_waitcnt lgkmcnt(" #n ")" ::: "memory")
#define PG8_BAR __builtin_amdgcn_s_barrier()
#define PG8_SCHED __builtin_amdgcn_sched_barrier(0)
    Unit cur, nxt; int ui = 0;
    if (!S.next(0, cur)) return;
#define PG8_UNI(u) do { (u).pm = __builtin_amdgcn_readfirstlane((u).pm); (u).pn = __builtin_amdgcn_readfirstlane((u).pn); (u).z = __builtin_amdgcn_readfirstlane((u).z); } while (0)
    PG8_UNI(cur);
    f32x4 acc[2][2][4][2];
#pragma unroll
    for (int a = 0; a < 2; ++a)
#pragma unroll
        for (int b = 0; b < 2; ++b)
#pragma unroll
            for (int m = 0; m < 4; ++m)
#pragma unroll
                for (int n = 0; n < 2; ++n) acc[a][b][m][n] = (f32x4){0.f, 0.f, 0.f, 0.f};
    bf16x8 At[4][2], B0[2][2], B1[2][2];
    const char* cA = (const char*)g.A + (size_t)cur.pm * tstepA + cur.aoff; const char* cB = (const char*)g.Bt + (size_t)cur.pn * tstepB + cur.boff;
    PG8_STAGE(PG8_SB(0, 0), cB, voffB); PG8_STAGE(PG8_SB(0, 1), cB + hstepB, voffB); PG8_STAGE(PG8_SA(0, 0), cA, voffA); PG8_STAGE(PG8_SA(0, 1), cA + hstepA, voffA);
    if (wr == 1) PG8_BAR;
    PG8_WAIT_V(2); PG8_BAR;
    PG8_STAGE(PG8_SB(1, 0), cB + kstep, voffB); PG8_STAGE(PG8_SA(1, 0), cA + kstep, voffA); PG8_STAGE(PG8_SB(1, 1), cB + hstepB + kstep, voffB);
    PG8_WAIT_V(6); PG8_BAR;
    for (;;) {
        const bool has_next = S.next(ui + 1, nxt); PG8_UNI(nxt);
        const char* nA = has_next ? (const char*)g.A + (size_t)nxt.pm * tstepA + nxt.aoff : cA; const char* nB = has_next ? (const char*)g.Bt + (size_t)nxt.pn * tstepB + nxt.boff : cB;
        for (int t = 0; t < nt; t += 2) {
            const bool last = (t == nt - 2);
            const char* a1 = cA + (size_t)(t + 1) * kstep;
            const char* a2 = last ? nA : cA + (size_t)(t + 2) * kstep; const char* b2 = last ? nB : cB + (size_t)(t + 2) * kstep;
            const char* a3 = a2 + kstep; const char* b3 = b2 + kstep;
            PG8_LDB(B0, 0, 0); PG8_LDB(B1, 0, 1); PG8_SCHED; PG8_LDA(At, 0, 0); PG8_STAGE(PG8_SA(1, 1), a1 + hstepA, voffA);
            PG8_WAIT_V(8); PG8_WAIT_L(0); PG8_BAR; PG8_MMA(0, 0, At, B0); PG8_MMA(0, 1, At, B1); PG8_BAR; PG8_SCHED;
            PG8_LDA(At, 0, 1); PG8_STAGE(PG8_SB(0, 0), b2, voffB); PG8_STAGE(PG8_SB(0, 1), b2 + hstepB, voffB); PG8_STAGE(PG8_SA(0, 0), a2, voffA);
            PG8_WAIT_V(8); PG8_WAIT_L(0); PG8_BAR; PG8_MMA(1, 0, At, B0); PG8_MMA(1, 1, At, B1); PG8_BAR; PG8_SCHED;
            PG8_LDB(B0, 1, 0); PG8_LDB(B1, 1, 1); PG8_SCHED; PG8_LDA(At, 1, 0); PG8_STAGE(PG8_SA(0, 1), a2 + hstepA, voffA);
            PG8_WAIT_V(8); PG8_WAIT_L(0); PG8_BAR; PG8_MMA(0, 0, At, B0); PG8_MMA(0, 1, At, B1); PG8_BAR; PG8_SCHED;
            PG8_LDA(At, 1, 1); PG8_STAGE(PG8_SB(1, 0), b3, voffB); PG8_STAGE(PG8_SB(1, 1), b3 + hstepB, voffB); PG8_STAGE(PG8_SA(1, 0), a3, voffA);
            PG8_WAIT_V(8); PG8_WAIT_L(0); PG8_BAR; PG8_MMA(1, 0, At, B0); PG8_MMA(1, 1, At, B1); PG8_BAR; PG8_SCHED;
        }
        if (wr == 0) PG8_BAR;
        E(acc, cur, wr, wc, fr, fq);
        if (!has_next) break;
#pragma unroll
        for (int a = 0; a < 2; ++a)
#pragma unroll
            for (int b = 0; b < 2; ++b)
#pragma unroll
                for (int m = 0; m < 4; ++m)
#pragma unroll
                    for (int n = 0; n < 2; ++n) acc[a][b][m][n] = (f32x4){0.f, 0.f, 0.f, 0.f};
        cur = nxt; cA = nA; cB = nB; ++ui;
        if (wr == 1) PG8_BAR;
    }
    PG8_WAIT_V(0);
    PG8_BAR;
#undef PG8_SA
#undef PG8_SB
#undef PG8_STAGE
#undef PG8_LDA
#undef PG8_LDB
#undef PG8_MMA
#undef PG8_WAIT_V
#undef PG8_WAIT_L
#undef PG8_BAR
#undef PG8_SCHED
#undef PG8_UNI
}
}
namespace attn_body {
using bf16 = __hip_bfloat16;
constexpr int D = 64, NW = 8, QBLK = 32, QB = QBLK * NW, KVBLK = 64;
__device__ __forceinline__ int crow(int r, int hi) { return (r & 3) + 8 * (r >> 2) + 4 * hi; }
#define SBAR() __builtin_amdgcn_sched_barrier(0)
constexpr int NSLOT = 3, SLOTB = 8192;
constexpr int LDS_K = 0, LDS_V = NSLOT * SLOTB, LDS_WS = 2 * NSLOT * SLOTB, LDS_OST = LDS_WS + NW * 64 * 4, LDS_BYTES = LDS_OST + NW * 4096;
__device__ __forceinline__ void glds16(const void* gsrc, unsigned lds_dst) { unsigned keep;
  asm volatile("s_mov_b32 %0, m0\n\ts_mov_b32 m0, %2\n\ts_nop 0\n\tglobal_load_lds_dwordx4 %1, off\n\ts_mov_b32 m0, %0" : "=&s"(keep) : "v"(gsrc), "s"(lds_dst) : "memory"); }
__device__ __forceinline__ float max3f(float a, float b, float c) { float r; asm("v_max3_f32 %0, %1, %2, %3" : "=v"(r) : "v"(a), "v"(b), "v"(c)); return r; }
__device__ __forceinline__ float max2f(float a, float b) { float r; asm("v_max_f32_e32 %0, %1, %2" : "=v"(r) : "v"(a), "v"(b)); return r; }
__device__ __forceinline__ float fadd_s(float a, float b) { float r; asm("v_add_f32_e32 %0, %1, %2" : "=v"(r) : "v"(a), "v"(b)); return r; }
__device__ __forceinline__ float fsub_s(float a, float b) { float r; asm("v_sub_f32_e32 %0, %1, %2" : "=v"(r) : "v"(a), "v"(b)); return r; }
typedef float f32x2_t __attribute__((ext_vector_type(2))); typedef __bf16 bf16x2_t __attribute__((ext_vector_type(2)));
__device__ __forceinline__ unsigned cvtpk_s(float lo, float hi) { f32x2_t v = {lo, hi}; bf16x2_t b = __builtin_convertvector(v, bf16x2_t); return __builtin_bit_cast(unsigned, b); }
#define WAIT_BAR(N) asm volatile("s_waitcnt vmcnt(" #N ") lgkmcnt(0)\n\ts_barrier" ::: "memory")
__device__ __forceinline__ void qkt(f32x16& p0, f32x16& p1, const char* Kslot, const bf16x8* qr, const f32x16& negm, int r32, int hi) {
  const char* kb = Kslot + hi * 1024 + r32 * 16;
#pragma unroll
  for (int d0 = 0; d0 < 4; ++d0) {
    const bf16x8 b0 = *reinterpret_cast<const bf16x8*>(kb + d0 * 2048);
    const bf16x8 b1 = *reinterpret_cast<const bf16x8*>(kb + d0 * 2048 + 512);
    if (d0 == 0) { p0 = __builtin_amdgcn_mfma_f32_32x32x16_bf16(b0, qr[0], negm, 0, 0, 0); p1 = __builtin_amdgcn_mfma_f32_32x32x16_bf16(b1, qr[0], negm, 0, 0, 0); }
    else { p0 = __builtin_amdgcn_mfma_f32_32x32x16_bf16(b0, qr[d0], p0, 0, 0, 0); p1 = __builtin_amdgcn_mfma_f32_32x32x16_bf16(b1, qr[d0], p1, 0, 0, 0); } }
}
typedef __attribute__((address_space(3))) const char* lds_cptr;
typedef short v4i16_t __attribute__((ext_vector_type(4)));
__device__ __forceinline__ void kload8(bf16x8* kf, lds_cptr kp) {
  kf[0] = *(const LAS bf16x8*)(kp);        kf[1] = *(const LAS bf16x8*)(kp + 512);
  kf[2] = *(const LAS bf16x8*)(kp + 2048); kf[3] = *(const LAS bf16x8*)(kp + 2560);
  kf[4] = *(const LAS bf16x8*)(kp + 4096); kf[5] = *(const LAS bf16x8*)(kp + 4608);
  kf[6] = *(const LAS bf16x8*)(kp + 6144); kf[7] = *(const LAS bf16x8*)(kp + 6656);
}
__device__ __forceinline__ void kload2(bf16x8* kf, lds_cptr kp, int j) { kf[2 * j] = *(const LAS bf16x8*)(kp + j * 2048); kf[2 * j + 1] = *(const LAS bf16x8*)(kp + j * 2048 + 512); }
__device__ __forceinline__ s16x4 vtr(lds_cptr p) { return __builtin_bit_cast(s16x4, __builtin_amdgcn_ds_read_tr16_b64_v4i16((LAS v4i16_t*)p)); }
__device__ __forceinline__ float rowmax(const f32x16& p0, const f32x16& p1) {
  float a = max3f(p0[0], p0[1], p1[0]), b = max3f(p0[2], p0[3], p1[1]); a = max3f(a, p1[2], p1[3]);
#pragma unroll
  for (int r = 4; r < 16; r += 4) { a = max3f(a, p0[r], p0[r + 1]); b = max3f(b, p0[r + 2], p0[r + 3]); a = max3f(a, p1[r], p1[r + 1]); b = max3f(b, p1[r + 2], p1[r + 3]); }
  const float m = max2f(a, b);
  auto rr = __builtin_amdgcn_permlane32_swap(__float_as_uint(m), __float_as_uint(m), false, false);
  return max2f(__uint_as_float(rr[0]), __uint_as_float(rr[1]));
}
__device__ __forceinline__ void pv(f32x16* o, int vb, bf16x8 pa0, bf16x8 pa1, bf16x8 pa2, bf16x8 pa3) {
#pragma unroll
  for (int d0 = 0; d0 < 2; ++d0) { s16x4 lo[4], hi[4];
#pragma unroll
    for (int ks = 0; ks < 4; ++ks) {
      asm volatile("ds_read_b64_tr_b16 %0,%1 offset:%c2" : "=&v"(lo[ks]) : "v"(vb), "i"(d0 * 4096 + ks * 1024) : "memory");
      asm volatile("ds_read_b64_tr_b16 %0,%1 offset:%c2" : "=&v"(hi[ks]) : "v"(vb), "i"(d0 * 4096 + ks * 1024 + 512) : "memory"); }
    asm volatile("s_waitcnt lgkmcnt(0)" ::: "memory"); SBAR();
#define PK(k) (bf16x8){lo[k][0], lo[k][1], lo[k][2], lo[k][3], hi[k][0], hi[k][1], hi[k][2], hi[k][3]}
    o[d0] = __builtin_amdgcn_mfma_f32_32x32x16_bf16(pa0, PK(0), o[d0], 0, 0, 0);
    o[d0] = __builtin_amdgcn_mfma_f32_32x32x16_bf16(pa1, PK(1), o[d0], 0, 0, 0);
    o[d0] = __builtin_amdgcn_mfma_f32_32x32x16_bf16(pa2, PK(2), o[d0], 0, 0, 0);
    o[d0] = __builtin_amdgcn_mfma_f32_32x32x16_bf16(pa3, PK(3), o[d0], 0, 0, 0);
#undef PK
  }
}
struct NoHook { static constexpr bool ON = false; __device__ __forceinline__ void operator()(f32x16&, f32x16&, int, int, int, int, float) const {} };

template <int THRL, class RS, class Hook>
__device__ __forceinline__ void attn_unit(const bf16* Qw0, int QP, const bf16* __restrict__ Kb, const bf16* __restrict__ Vb, int KP, const RS rs, const int NT, bf16* Ow0, int OP, char* shm, const Hook hook) {
  const int tid = otid(), lane = tid & 63, r32 = lane & 31, hi = lane >> 5; const int wid = __builtin_amdgcn_readfirstlane(tid >> 6);
  const bf16* Qw = Qw0 + (long)(wid * QBLK) * QP;
  const unsigned lds0 = (unsigned)(uintptr_t)shm;
  float* wsf = (float*)(shm + LDS_WS) + wid * 64;
  const bf16* ksrc = Kb + (long)lane * KP + wid * 8;
  const bf16* vsrc = Vb + (long)(16 * (wid & 3) + (lane >> 2)) * KP + (wid >> 2) * 32 + (lane & 3) * 8;
  const unsigned kdst = lds0 + LDS_K + wid * 1024, vdst = lds0 + LDS_V + wid * 1024;
#define DMA_K(t, slot) glds16(ksrc + (long)rs(t) * KP, (unsigned)__builtin_amdgcn_readfirstlane(kdst + (slot)))
#define DMA_V(t, slot) glds16(vsrc + (long)rs(t) * KP, (unsigned)__builtin_amdgcn_readfirstlane(vdst + (slot)))
  const int vb0 = (int)(lds0 + LDS_V) + ((lane >> 4) & 1) * 32 + (lane & 3) * 8 + (4 * hi + ((lane & 15) >> 2)) * 64;
  const char* Kbase = shm + LDS_K; bf16x8 kf[8];
  const lds_cptr shm3 = (lds_cptr)shm; const lds_cptr kp0 = shm3 + LDS_K + hi * 1024 + r32 * 16; const lds_cptr vp0 = shm3 + LDS_V + ((lane >> 4) & 1) * 32 + (lane & 3) * 8 + (4 * hi + ((lane & 15) >> 2)) * 64;
  DMA_K(0, 0); DMA_V(0, 0); DMA_K(1, SLOTB);
  bf16x8 qr[4];
#pragma unroll
  for (int d0 = 0; d0 < 4; ++d0) qr[d0] = *(const GAS bf16x8*)(&Qw[(long)r32 * QP + d0 * 16 + hi * 8]);
  constexpr bool NONEGM = Hook::ON;
  float mhat = 0.f, l_reg = 0.f; f32x16 o[2]; o[0] = f32x16{}; o[1] = f32x16{}; f32x16 negm = f32x16{}; if constexpr (!NONEGM) asm volatile("" : "+v"(negm));
#define CMASK(P0, P1, t) do { if constexpr (Hook::ON) hook(P0, P1, (t), wid, r32, hi, mhat); } while (0)
  bool resc = false;
#define START(P0, P1) do { const float rm = rowmax(P0, P1); resc = false; \
    { const float dl = rm; mhat = fadd_s(mhat, dl); \
      _Pragma("unroll") for (int r = 0; r < 16; ++r) { P0[r] = fsub_s(P0[r], dl); P1[r] = fsub_s(P1[r], dl); } \
      if constexpr (!NONEGM) { _Pragma("unroll") for (int r = 0; r < 16; ++r) negm[r] = -mhat; asm volatile("" : "+v"(negm)); } } \
    _Pragma("unroll") for (int r = 0; r < 16; ++r) P0[r] = __builtin_amdgcn_exp2f(P0[r]); } while (0)
#define RESC() do { if (resc) { asm volatile("s_waitcnt lgkmcnt(0)" ::: "memory"); \
      _Pragma("unroll") for (int d_ = 0; d_ < 2; ++d_) _Pragma("unroll") for (int r = 0; r < 16; ++r) o[d_][r] *= wsf[crow(r, hi)]; } } while (0)
  f32x16 pA0, pA1, pB0, pB1;
  int sl_prev = 0, sl_cur = 0, sl_next = SLOTB;
#define ROT() do { sl_prev = sl_cur; sl_cur = sl_next; sl_next = (sl_next == (NSLOT - 1) * SLOTB) ? 0 : sl_next + SLOTB; } while (0)
  DMA_K(2, 2 * SLOTB);
  WAIT_BAR(3);
  qkt(pA0, pA1, Kbase, qr, negm, r32, hi); asm volatile("s_nop 15\n\ts_nop 7" : "+v"(pA0), "+v"(pA1)); CMASK(pA0, pA1, 0);
  START(pA0, pA1);
  _Pragma("unroll") for (int r = 0; r < 16; ++r) pA1[r] = __builtin_amdgcn_exp2f(pA1[r]);
  WAIT_BAR(0);
  DMA_K(3, 0); DMA_V(1, SLOTB);
  ROT();
  kload8(kf, kp0 + sl_cur);
  WAIT_BAR(2);
  s16x4 vlo[8], vhi[8]; u32x4 pw0, pw1, pw2, pw3;
#define PKW(P, B) cvtpk_s(P[B], P[B + 1])
#define PAF(k) __builtin_bit_cast(bf16x8, pw##k)
#define VFR(i) (bf16x8){vlo[i][0], vlo[i][1], vlo[i][2], vlo[i][3], vhi[i][0], vhi[i][1], vhi[i][2], vhi[i][3]}
#define PIN(x) asm volatile("" : "+v"(x))
#define MX3(a, b, c) __builtin_fmaxf(__builtin_fmaxf((a), (b)), (c))
#define GAPA(MF, A0, A1, A2, A3, W0, W1, PW) do { MF; sacc += A0; sacc += A1; sacc += A2; sacc += A3; PIN(sacc); W0; W1; PIN(PW); SBAR(); } while (0)
#define EX(v) __builtin_amdgcn_exp2f(v)
#define GAPB(MF, X, B) do { MF; X[B] = EX(X[B]); X[B + 1] = EX(X[B + 1]); X[B + 2] = EX(X[B + 2]); X[B + 3] = EX(X[B + 3]); PIN(X); SBAR(); } while (0)
#define VRD(i) do { vlo[i] = vtr(vp_ + (((i) >> 2) * 4096 + ((i) & 3) * 1024)); vhi[i] = vtr(vp_ + (((i) >> 2) * 4096 + ((i) & 3) * 1024 + 512)); } while (0)
#define KRD(G, j) do { if (G) { kload2(kf, kp0 + sl_next, j); SBAR(); } } while (0)
#define STEP(C0, C1, P0, P1, t, GK, GV, GL) do { SBAR(); \
    const lds_cptr vp_ = vp0 + sl_prev; \
    VRD(0); SBAR(); float sacc = (P0[0] + P0[1]); \
    GAPA(C0 = __builtin_amdgcn_mfma_f32_32x32x16_bf16(kf[0], qr[0], negm, 0, 0, 0), P0[2], P0[3], P0[4], P0[5],     pw0[0] = PKW(P0, 0), pw0[1] = PKW(P0, 2), pw0); \
    VRD(4); SBAR(); GAPA(C1 = __builtin_amdgcn_mfma_f32_32x32x16_bf16(kf[1], qr[0], negm, 0, 0, 0), P0[6], P0[7], P0[8], P0[9],     pw0[2] = PKW(P0, 4), pw0[3] = PKW(P0, 6), pw0); \
    VRD(1); SBAR(); GAPA(C0 = __builtin_amdgcn_mfma_f32_32x32x16_bf16(kf[2], qr[1], C0, 0, 0, 0),   P0[10], P0[11], P0[12], P0[13], pw1[0] = PKW(P0, 8), pw1[1] = PKW(P0, 10), pw1); \
    VRD(5); SBAR(); GAPA(C1 = __builtin_amdgcn_mfma_f32_32x32x16_bf16(kf[3], qr[1], C1, 0, 0, 0),   P0[14], P0[15], P1[0], P1[1],   pw1[2] = PKW(P0, 12), pw1[3] = PKW(P0, 14), pw1); \
    VRD(2); SBAR(); GAPA(C0 = __builtin_amdgcn_mfma_f32_32x32x16_bf16(kf[4], qr[2], C0, 0, 0, 0),   P1[2], P1[3], P1[4], P1[5],     pw2[0] = PKW(P1, 0), pw2[1] = PKW(P1, 2), pw2); \
    VRD(6); SBAR(); GAPA(C1 = __builtin_amdgcn_mfma_f32_32x32x16_bf16(kf[5], qr[2], C1, 0, 0, 0),   P1[6], P1[7], P1[8], P1[9],     pw2[2] = PKW(P1, 4), pw2[3] = PKW(P1, 6), pw2); \
    VRD(3); SBAR(); GAPA(C0 = __builtin_amdgcn_mfma_f32_32x32x16_bf16(kf[6], qr[3], C0, 0, 0, 0),   P1[10], P1[11], P1[12], P1[13], pw3[0] = PKW(P1, 8), pw3[1] = PKW(P1, 10), pw3); \
    VRD(7); SBAR(); GAPA(C1 = __builtin_amdgcn_mfma_f32_32x32x16_bf16(kf[7], qr[3], C1, 0, 0, 0),   P1[14], P1[15], 0.f, 0.f,       pw3[2] = PKW(P1, 12), pw3[3] = PKW(P1, 14), pw3); \
    l_reg += sacc; \
    if (GK) { DMA_K((t) + 3, sl_cur); } if (GV) { DMA_V((t) + 1, sl_next); } \
    CMASK(C0, C1, t); \
    { float a = MX3(C0[0], C0[1], C1[0]), b = MX3(C0[2], C0[3], C1[1]); a = MX3(a, C1[2], C1[3]); \
      _Pragma("unroll") for (int r = 4; r < 16; r += 4) { a = MX3(a, C0[r], C0[r + 1]); b = MX3(b, C0[r + 2], C0[r + 3]); a = MX3(a, C1[r], C1[r + 1]); b = MX3(b, C1[r + 2], C1[r + 3]); } \
      float rm = __builtin_fmaxf(a, b); { auto rr = __builtin_amdgcn_permlane32_swap(__float_as_uint(rm), __float_as_uint(rm), false, false); rm = __builtin_fmaxf(__uint_as_float(rr[0]), __uint_as_float(rr[1])); } \
      resc = false; \
      if (__builtin_expect(__any(rm > (float)THRL), 0)) { const float dl = __builtin_fmaxf(rm, 0.f); mhat += dl; \
        _Pragma("unroll") for (int r = 0; r < 16; ++r) { C0[r] -= dl; C1[r] -= dl; } \
        if constexpr (!NONEGM) { _Pragma("unroll") for (int r = 0; r < 16; ++r) negm[r] = -mhat; asm volatile("" : "+v"(negm)); } \
        const float f = __builtin_amdgcn_exp2f(-dl); l_reg *= f; if (hi == 0) wsf[r32] = f; resc = true; } } \
    SBAR(); \
    GAPB(o[0] = __builtin_amdgcn_mfma_f32_32x32x16_bf16(PAF(0), VFR(0), o[0], 0, 0, 0), C0, 0); \
    GAPB(o[1] = __builtin_amdgcn_mfma_f32_32x32x16_bf16(PAF(0), VFR(4), o[1], 0, 0, 0), C0, 4); \
    KRD(GL, 0); GAPB(o[0] = __builtin_amdgcn_mfma_f32_32x32x16_bf16(PAF(1), VFR(1), o[0], 0, 0, 0), C0, 8); \
    KRD(GL, 1); GAPB(o[1] = __builtin_amdgcn_mfma_f32_32x32x16_bf16(PAF(1), VFR(5), o[1], 0, 0, 0), C0, 12); \
    KRD(GL, 2); GAPB(o[0] = __builtin_amdgcn_mfma_f32_32x32x16_bf16(PAF(2), VFR(2), o[0], 0, 0, 0), C1, 0); \
    KRD(GL, 3); GAPB(o[1] = __builtin_amdgcn_mfma_f32_32x32x16_bf16(PAF(2), VFR(6), o[1], 0, 0, 0), C1, 4); \
    GAPB(o[0] = __builtin_amdgcn_mfma_f32_32x32x16_bf16(PAF(3), VFR(3), o[0], 0, 0, 0), C1, 8); \
    GAPB(o[1] = __builtin_amdgcn_mfma_f32_32x32x16_bf16(PAF(3), VFR(7), o[1], 0, 0, 0), C1, 12); \
    } while (0)
  int t = 1;
  for (; t + 5 < NT; t += 2) {
    STEP(pB0, pB1, pA0, pA1, t, true, true, true);     WAIT_BAR(2); RESC(); ROT();
    STEP(pA0, pA1, pB0, pB1, t + 1, true, true, true); WAIT_BAR(2); RESC(); ROT();
  }
#define ENDW(tt) do { if ((tt) + 3 < NT) { WAIT_BAR(2); } else if ((tt) + 2 < NT) { WAIT_BAR(1); } else { WAIT_BAR(0); } } while (0)
  for (; t + 1 < NT; t += 2) {
    STEP(pB0, pB1, pA0, pA1, t, (t + 3 < NT), (t + 1 < NT), (t + 1 < NT));         ENDW(t);     RESC(); ROT();
    STEP(pA0, pA1, pB0, pB1, t + 1, (t + 4 < NT), (t + 2 < NT), (t + 2 < NT));     ENDW(t + 1); RESC(); ROT();
  }
  STEP(pB0, pB1, pA0, pA1, NT - 1, false, false, false); RESC();
  { float sacc = pB0[0] + pB0[1]; _Pragma("unroll") for (int r = 2; r < 16; ++r) sacc += pB0[r]; _Pragma("unroll") for (int r = 0; r < 16; ++r) sacc += pB1[r]; l_reg += sacc;
    pw0 = (u32x4){PKW(pB0, 0), PKW(pB0, 2), PKW(pB0, 4), PKW(pB0, 6)}; pw1 = (u32x4){PKW(pB0, 8), PKW(pB0, 10), PKW(pB0, 12), PKW(pB0, 14)}; pw2 = (u32x4){PKW(pB1, 0), PKW(pB1, 2), PKW(pB1, 4), PKW(pB1, 6)}; pw3 = (u32x4){PKW(pB1, 8), PKW(pB1, 10), PKW(pB1, 12), PKW(pB1, 14)};
    SBAR(); pv(o, vb0 + sl_cur, PAF(0), PAF(1), PAF(2), PAF(3)); }
#undef PKW
#undef PAF
#undef VFR
#undef PIN
#undef MX3
#undef GAPA
#undef GAPB
#undef EX
#undef VRD
#undef KRD
#undef STEP
#undef ENDW
  { auto rr = __builtin_amdgcn_permlane32_swap(__float_as_uint(l_reg), __float_as_uint(l_reg), false, false); l_reg = __uint_as_float(rr[0]) + __uint_as_float(rr[1]); }
  if (hi == 0) wsf[32 + r32] = l_reg; asm volatile("s_waitcnt lgkmcnt(0)" ::: "memory");
  float rli[16];
#pragma unroll
  for (int r = 0; r < 16; ++r) rli[r] = __builtin_amdgcn_rcpf(wsf[32 + crow(r, hi)]);
  bf16* Ow = Ow0 + (long)(wid * QBLK) * OP;
  { bf16* stg = (bf16*)(shm + LDS_OST) + wid * 2048;
#pragma unroll
    for (int r = 0; r < 16; ++r) { const int orow = crow(r, hi);
#pragma unroll
      for (int d0 = 0; d0 < 2; ++d0) stg[orow * 64 + d0 * 32 + r32] = __float2bfloat16(o[d0][r] * rli[r]); }
    asm volatile("s_waitcnt lgkmcnt(0)" ::: "memory");
#pragma unroll
    for (int i = 0; i < 4; ++i) { const int row = i * 8 + (lane >> 3), ch = lane & 7; const u32x4 v = *(const u32x4*)(stg + row * 64 + ch * 8); *(GAS u32x4*)(Ow + (long)row * OP + ch * 8) = v; } }
  asm volatile("s_waitcnt lgkmcnt(0)\n\ts_barrier" ::: "memory");
#undef DMA_K
#undef DMA_V
#undef CMASK
#undef START
#undef RESC
#undef ROT
}
#undef SBAR
#undef WAIT_BAR
}
#define XB_TMO      128
#define XB_XCNT(j)  (256  + 64 * (j))
#define XB_XSUB(j)  (1280 + 64 * (j))
#define XB_XGEN(j)  (2304 + 64 * (j))
#define XB_TOP      3328
#define XB_TOPGEN   3392
#define XCD_BAR_WORDS 3456
#define XB_SPIN_CAP (1u << 20)
__device__ __forceinline__ unsigned xb_ld(unsigned* p)              { return __hip_atomic_load(p, __ATOMIC_RELAXED, __HIP_MEMORY_SCOPE_AGENT); }
__device__ __forceinline__ unsigned xb_add(unsigned* p, unsigned v) { return __hip_atomic_fetch_add(p, v, __ATOMIC_RELAXED, __HIP_MEMORY_SCOPE_AGENT); }
__device__ __forceinline__ unsigned xb_xcc_id() { return (unsigned)__builtin_amdgcn_s_getreg((3 << 11) | 20) & 0xFu; }
#define XB_SPIN(cond, bar) do { unsigned _sp = 0; while (cond) { __builtin_amdgcn_s_sleep(1); \
    if ((++_sp & 255u) == 0u) { if (xb_ld(&(bar)[XB_TMO])) break; if (_sp > XB_SPIN_CAP) { atomicAdd(&(bar)[XB_TMO], 1u); break; } } } } while (0)
struct XcdBarrier { unsigned* bar; unsigned x; volatile LAS unsigned* st; };
__device__ __forceinline__ XcdBarrier xcd_barrier_post(unsigned* bar, volatile LAS unsigned* st) {
    XcdBarrier b; b.bar = bar; b.x = xb_xcc_id(); b.st = st;
    if (otid() == 0) (void)xb_add(&bar[XB_XCNT(b.x)], 1u);
    return b;
}
__device__ __forceinline__ void xcd_barrier_complete(unsigned* bar, unsigned x, unsigned& nloc, unsigned& nx) {
    const unsigned G = gridDim.x * gridDim.y * gridDim.z;
    unsigned sum, cnt, mine, sp = 0u;
    for (;;) {
        sum = 0u; cnt = 0u; mine = 0u;
#pragma unroll
        for (unsigned j = 0; j < 16; ++j) { const unsigned c = xb_ld(&bar[XB_XCNT(j)]); sum += c; cnt += (c > 0u) ? 1u : 0u; mine = (j == x) ? c : mine; }
        if (sum == G) break;
        __builtin_amdgcn_s_sleep(1);
        if ((++sp & 255u) == 0u) { if (xb_ld(&bar[XB_TMO])) break; if (sp > XB_SPIN_CAP) { atomicAdd(&bar[XB_TMO], 1u); break; } }
    }
    nloc = mine > 0u ? mine : 1u; nx = cnt > 0u ? cnt : 1u;
}
__device__ __forceinline__ void xcd_barrier(const XcdBarrier& b) {
    asm volatile("s_waitcnt vmcnt(0)" ::: "memory");
    __syncthreads();
    if (otid() == 0) {
        unsigned* bar = b.bar;
        __builtin_amdgcn_s_waitcnt(0);
        unsigned nloc = b.st[0], nx = b.st[1];
        if (nloc == 0u) { xcd_barrier_complete(bar, b.x, nloc, nx); b.st[0] = nloc; b.st[1] = nx; }
        const unsigned old = xb_add(&bar[XB_XSUB(b.x)], 1u);
        const unsigned gen = old / nloc;
        if (old + 1u == (gen + 1u) * nloc) {
            __builtin_amdgcn_fence(__ATOMIC_RELEASE, "agent");
            asm volatile("s_waitcnt vmcnt(0)" ::: "memory");
            const unsigned og = xb_add(&bar[XB_TOP], 1u);
            const unsigned tg = og / nx;
            if (og + 1u == (tg + 1u) * nx) xb_add(&bar[XB_TOPGEN], 1u);
            else XB_SPIN(xb_ld(&bar[XB_TOPGEN]) == tg, bar);
            __builtin_amdgcn_fence(__ATOMIC_ACQUIRE, "agent");
            xb_add(&bar[XB_XGEN(b.x)], 1u);
            asm volatile("s_waitcnt vmcnt(0)" ::: "memory");
        } else {
            XB_SPIN(xb_ld(&bar[XB_XGEN(b.x)]) == gen, bar);
            __builtin_amdgcn_fence(__ATOMIC_ACQUIRE, "agent");
            asm volatile("s_waitcnt vmcnt(0)" ::: "memory");
        }
    }
    __syncthreads();
}
constexpr size_t MiB = (size_t)1 << 20;
constexpr size_t WS_CTL = 0, CTL_BYTES = 1 * MiB;
constexpr size_t WS_MODV = 1 * MiB;
constexpr size_t WS_S5AL = WS_MODV + 256 * 1024;
constexpr size_t WS_ROUTE = 2 * MiB;
constexpr size_t WS_XCTX = 3 * MiB;
constexpr size_t WS_WG1 = 5 * MiB;
constexpr size_t WS_WBR = 23 * MiB;
constexpr size_t WS_WOUT = 27 * MiB;
constexpr size_t WS_WGLU = 29 * MiB;
constexpr size_t WS_S5BS = 30 * MiB;
constexpr size_t WS_S5BO = 38 * MiB;
constexpr size_t WS_HB = 62 * MiB;
constexpr size_t WS_A = 95 * MiB;
constexpr size_t WS_B = 405 * MiB;
constexpr size_t WS_C = 488 * MiB;
constexpr size_t WS_END = 540 * MiB;
constexpr size_t SZ512 = (size_t)RT * 512 * 2;
constexpr size_t A_UH = 0;
constexpr size_t A_P512 = 36 * MiB;
constexpr size_t A_GQK = A_P512 + 8 * SZ512, A_GQV = A_GQK + (size_t)RT * 128 * 2, A_MLG = A_GQV + (size_t)RT * 128 * 2;
constexpr size_t A_GATE = 178 * MiB;
constexpr size_t A_MSUM = 0;
constexpr size_t A_W13 = 0, A_W2 = 64 * MiB, A_MBUF = 96 * MiB, A_MH = 178 * MiB, A_MY = 219 * MiB;
static_assert(A_MLG + (size_t)RT * 16 * 4 <= A_GATE && A_GATE + (size_t)RT * 4096 * 2 <= 310 * MiB && A_MY + (size_t)MOE_MAXROWS * 1024 * 2 <= 310 * MiB, "region A");
constexpr size_t B_Z = 4 * SZ512;
constexpr size_t C_CST = 0, C_NST = 33 * MiB, C_DEC = C_NST + 768 * 1024, C_SST = 34 * MiB;
constexpr int CW_BAR = 4096, CW_CNT = 8192;
constexpr int NA_TAB_OFF = 86016;

__device__ __forceinline__ float* xrow_ptr(float* out, float* xctx, int row) { const int b = row / SB, s = row - b * SB; return s < CTX ? xctx + (size_t)(b * CTX + s) * DM : out + ((size_t)b * SEQ + (s - CTX)) * DM; }
__device__ __forceinline__ int modsel(int row) { const int b = row / SB, s = row - b * SB; return s < CTX ? 2 : b; }

template <class RowMap>
__device__ __forceinline__ void tr_item(const float* Wc, int ld, int k0, int nvalid, bf16_t* WT, int ldo, const RowMap rm, LAS float* scr, int lane) {
    float tv[32];
#pragma unroll
    for (int i = 0; i < 32; ++i) { const int kk = 2 * i + (lane >> 5), n = lane & 31; tv[i] = *(const GAS float*)(Wc + (size_t)(k0 + kk) * ld + (n < nvalid ? n : nvalid - 1)); }
#pragma unroll
    for (int i = 0; i < 32; ++i) { const int kk = 2 * i + (lane >> 5), n = lane & 31; scr[kk * 33 + n] = tv[i]; }
    asm volatile("s_waitcnt lgkmcnt(0)" ::: "memory");
    const int c = lane & 7;
#pragma unroll
    for (int j = 0; j < 4; ++j) { const int n = (lane >> 3) + 8 * j; const LAS float* s = scr + (8 * c) * 33 + n;
        u32x4 o; o.x = pk2(s[0 * 33], s[1 * 33]); o.y = pk2(s[2 * 33], s[3 * 33]); o.z = pk2(s[4 * 33], s[5 * 33]); o.w = pk2(s[6 * 33], s[7 * 33]);
        if (n < nvalid) *(GAS u32x4*)(WT + (size_t)rm(n) * ldo + k0 + 8 * c) = o; }
    asm volatile("s_waitcnt lgkmcnt(0)" ::: "memory");
}
struct RmAffine { int r0; __device__ __forceinline__ int operator()(int n) const { return r0 + n; } };
struct RmMoe13 { int r0, n0; __device__ __forceinline__ int operator()(int n) const { const int h = n0 + n; return r0 + (h >> 2) * 8 + (h & 3); } };

__device__ __forceinline__ void conv_layer_weights(const float* w_in, const float* w_gate, const float* w_branch, const float* w_out, const float* w_glu,
                                                   unsigned char* ws, LAS float* scr, int gw, int NGW, int lane) {
    bf16_t* WG1 = (bf16_t*)(ws + WS_WG1); bf16_t* WBR = (bf16_t*)(ws + WS_WBR); bf16_t* WOUT = (bf16_t*)(ws + WS_WOUT); bf16_t* WGLU = (bf16_t*)(ws + WS_WGLU);
    constexpr int I1 = 16 * 128, I2 = 16, I3 = 16 * 24, I4 = 16 * 128, I5 = 4 * 8 * 32, I6 = 16 * 32, I7 = 8 * 16, NIT = I1 + I2 + I3 + I4 + I5 + I6 + I7;
    for (int it = gw; it < NIT; it += NGW) {
        int r = it;
        if (r < I1) { const int kb = r / 128, nb = r % 128; tr_item(w_in + 32 * nb, 4880, 64 * kb, 32, WG1, 1024, RmAffine{32 * nb}, scr, lane); continue; } r -= I1;
        if (r < I2) { tr_item(w_in + 4096, 4880, 64 * r, 16, WG1, 1024, RmAffine{4864}, scr, lane); continue; } r -= I2;
        if (r < I3) { const int kb = r / 24, nb = r % 24; tr_item(w_in + 4112 + 32 * nb, 4880, 64 * kb, 32, WG1, 1024, RmAffine{4096 + 32 * nb}, scr, lane); continue; } r -= I3;
        if (r < I4) { const int kb = r / 128, nb = r % 128; tr_item(w_gate + 32 * nb, 4096, 64 * kb, 32, WG1, 1024, RmAffine{5120 + 32 * nb}, scr, lane); continue; } r -= I4;
        if (r < I5) { const int i = r / 256, q = r % 256, kb = q / 32, nb = q % 32; tr_item(w_branch + (size_t)i * 512 * 1024 + 32 * nb, 1024, 64 * kb, 32, WBR + (size_t)i * 1024 * 512, 512, RmAffine{32 * nb}, scr, lane); continue; } r -= I5;
        if (r < I6) { const int kb = r / 32, nb = r % 32; tr_item(w_out + 32 * nb, 1024, 64 * kb, 32, WOUT, 1024, RmAffine{32 * nb}, scr, lane); continue; } r -= I6;
        { const int kb = r / 16, nb = r % 16; tr_item(w_glu + 32 * nb, 512, 64 * kb, 32, WGLU, 512, RmAffine{32 * nb}, scr, lane); }
    }
}
__device__ __forceinline__ void conv_moe_weights(const float* w1, const float* w3, const float* w2, unsigned char* ws, LAS float* scr, int gw, int NGW, int lane) {
    bf16_t* W13 = (bf16_t*)(ws + WS_A + A_W13); bf16_t* W2T = (bf16_t*)(ws + WS_A + A_W2);
    constexpr int PER = 256 + 256 + 256, NIT = 32 * PER;
    for (int it = gw; it < NIT; it += NGW) {
        const int e = it / PER; int r = it % PER;
        if (r < 256) { const int kb = r / 16, nb = r % 16; tr_item(w1 + (size_t)e * 1024 * 512 + 32 * nb, 512, 64 * kb, 32, W13, 1024, RmMoe13{e * 1024, 32 * nb}, scr, lane); continue; } r -= 256;
        if (r < 256) { const int kb = r / 16, nb = r % 16; tr_item(w3 + (size_t)e * 1024 * 512 + 32 * nb, 512, 64 * kb, 32, W13, 1024, RmMoe13{e * 1024 + 4, 32 * nb}, scr, lane); continue; } r -= 256;
        { const int kb = r / 32, nb = r % 32; tr_item(w2 + (size_t)e * 512 * 1024 + 32 * nb, 1024, 64 * kb, 32, W2T, 512, RmAffine{e * 1024 + 32 * nb}, scr, lane); }
    }
}

__device__ __forceinline__ void s5_precompute(int l, int g, int j8, const float* lam_re, const float* lam_im, const float* log_dt, const float* b_re, const float* b_im,
                                              const float* c_re, const float* c_im, const float* d_skip, unsigned char* ws, LAS unsigned char* lds) {
    const int tid = otid();
    LAS f32x2* apw = (LAS f32x2*)lds;
    LAS f32x2* bbar = (LAS f32x2*)(lds + 33792);
    LAS f32x2* ccv = (LAS f32x2*)(lds + 33792 + 16384);
    LAS float* Kt = (LAS float*)(lds + 33792 + 32768);
    float* AL = (float*)(ws + WS_S5AL);
    if (tid < 128) {
        const int d = tid >> 6, p = tid & 63; const size_t gi = ((size_t)(l * 2 + d) * 32 + g);
        const GAS float* g_bre = (const GAS float*)b_re + (gi * 64 + p) * 16; const GAS float* g_bim = (const GAS float*)b_im + (gi * 64 + p) * 16;
        const GAS float* g_cre = (const GAS float*)c_re + gi * 16 * 64 + p; const GAS float* g_cim = (const GAS float*)c_im + gi * 16 * 64 + p;
        f32x4 brv[4], biv[4]; float crv[16], civ[16];
#pragma unroll
        for (int q = 0; q < 4; ++q) { brv[q] = ((const GAS f32x4*)g_bre)[q]; biv[q] = ((const GAS f32x4*)g_bim)[q]; }
#pragma unroll
        for (int ch = 0; ch < 16; ++ch) { crv[ch] = g_cre[ch * 64]; civ[ch] = g_cim[ch * 64]; }
        const float dt = __expf(((const GAS float*)log_dt)[gi]); const float lr = ((const GAS float*)lam_re)[gi * 64 + p], li = ((const GAS float*)lam_im)[gi * 64 + p];
        for (int tau = 0; tau <= 32; ++tau) { const float mag = __expf((float)tau * lr * dt), ang = (float)tau * li * dt; apw[(d * 64 + p) * 33 + tau] = (f32x2){mag * __cosf(ang), mag * __sinf(ang)}; }
        const f32x2 a = apw[(d * 64 + p) * 33 + 1]; const float nr = a.x - 1.f, den = lr * lr + li * li;
        const float fr_ = (nr * lr + a.y * li) / den, fi_ = (a.y * lr - nr * li) / den;
#pragma unroll
        for (int ch = 0; ch < 16; ++ch) { const float br = brv[ch >> 2][ch & 3], bi = biv[ch >> 2][ch & 3]; bbar[(d * 64 + p) * 16 + ch] = (f32x2){fr_ * br - fi_ * bi, fr_ * bi + fi_ * br}; }
#pragma unroll
        for (int ch = 0; ch < 16; ++ch) ccv[(d * 16 + ch) * 64 + p] = (f32x2){crv[ch], civ[ch]};
        if (j8 == 0) { const f32x2 a32 = apw[(d * 64 + p) * 33 + 32]; AL[((d * 32 + g) * 64 + p) * 2 + 0] = a32.x; AL[((d * 32 + g) * 64 + p) * 2 + 1] = a32.y; }
    }
    __syncthreads();
    for (int e = tid; e < 2 * 4 * 256; e += 512) {
        const int d = e >> 10, tl = (e >> 8) & 3, ch = (e >> 4) & 15, c2 = e & 15, tau = 4 * j8 + tl; float s = 0.f;
        for (int p = 0; p < 64; ++p) { const f32x2 c = ccv[(d * 16 + ch) * 64 + p], a = apw[(d * 64 + p) * 33 + tau], bb = bbar[(d * 64 + p) * 16 + c2];
            const float car = c.x * a.x - c.y * a.y, cai = c.x * a.y + c.y * a.x; s += car * bb.x - cai * bb.y; }
        Kt[e] = s;
    }
    __syncthreads();
    bf16_t* BO = (bf16_t*)(ws + WS_S5BO) + (size_t)g * 512 * 768;
    for (int q = tid; q < 4 * 2 * 32 * 32; q += 512) {
        const int tl = q >> 11, dir = (q >> 10) & 1, pos = (q >> 5) & 31, ch = (q >> 1) & 15, hf = q & 1, tau = 4 * j8 + tl;
        if (pos > 31 - tau || (tau == 0 && dir == 1)) continue;
        const int jj = dir ? pos : pos + tau, ii = dir ? pos + tau : pos; float v[8];
#pragma unroll
        for (int e = 0; e < 8; ++e) { const int c2 = hf * 8 + e; float t = Kt[((dir * 4 + tl) * 16 + ch) * 16 + c2];
            if (tau == 0) { t += Kt[((1 * 4 + tl) * 16 + ch) * 16 + c2]; if (ch == c2) t += ((const GAS float*)d_skip)[l * 512 + g * 16 + ch]; }
            v[e] = t; }
        u32x4 o; o.x = pk2(v[0], v[1]); o.y = pk2(v[2], v[3]); o.z = pk2(v[4], v[5]); o.w = pk2(v[6], v[7]);
        *(GAS u32x4*)(BO + (size_t)(jj * 16 + ch) * 768 + ii * 16 + hf * 8) = o;
    }
    for (int q = tid; q < 64 * 32; q += 512) {
        const int n = 64 * j8 + (q >> 5), k8 = 512 + (q & 31) * 8, j = n >> 4, ch = n & 15; float v[8];
        const int d = (k8 >= 640) ? 1 : 0, p0 = ((k8 - 512) & 127) >> 1, tau = d ? (32 - j) : (j + 1);
#pragma unroll
        for (int e = 0; e < 4; ++e) { const f32x2 c = ccv[(d * 16 + ch) * 64 + p0 + e], a = apw[(d * 64 + p0 + e) * 33 + tau]; v[2 * e] = c.x * a.x - c.y * a.y; v[2 * e + 1] = -(c.x * a.y + c.y * a.x); }
        u32x4 o; o.x = pk2(v[0], v[1]); o.y = pk2(v[2], v[3]); o.z = pk2(v[4], v[5]); o.w = pk2(v[6], v[7]);
        *(GAS u32x4*)(BO + (size_t)n * 768 + k8) = o;
    }
    bf16_t* BS = (bf16_t*)(ws + WS_S5BS) + (size_t)g * 256 * 512;
    for (int q = tid; q < 32 * 64; q += 512) {
        const int n = 32 * j8 + (q >> 6), k8 = (q & 63) * 8, d = n >> 7, p = (n >> 1) & 63, ri = n & 1, i = k8 >> 4, c0 = k8 & 15, tau = d ? i : (31 - i); float v[8];
        const f32x2 a = apw[(d * 64 + p) * 33 + tau];
#pragma unroll
        for (int e = 0; e < 8; ++e) { const f32x2 bb = bbar[(d * 64 + p) * 16 + c0 + e]; v[e] = ri ? (a.x * bb.y + a.y * bb.x) : (a.x * bb.x - a.y * bb.y); }
        u32x4 o; o.x = pk2(v[0], v[1]); o.y = pk2(v[2], v[3]); o.z = pk2(v[4], v[5]); o.w = pk2(v[6], v[7]);
        *(GAS u32x4*)(BS + (size_t)n * 512 + k8) = o;
    }
    __syncthreads();
}

__device__ __forceinline__ void modv_item(int item, const float* w_mod, const float* b_mod, float* MODV, const LAS float* scs, LAS float* part, int wave, int lane) {
    const int l = item / 96, col = (item % 96) * 64 + lane; const GAS float* w = (const GAS float*)w_mod + (size_t)l * 1024 * 6144 + (size_t)(wave * 128) * 6144 + col;
    float a0 = 0.f, a1 = 0.f, a2 = 0.f;
#pragma unroll 32
    for (int k = 0; k < 128; ++k) { const float wv = w[(size_t)k * 6144]; a0 += scs[wave * 128 + k] * wv; a1 += scs[1024 + wave * 128 + k] * wv; a2 += scs[2048 + wave * 128 + k] * wv; }
    part[(wave * 3 + 0) * 64 + lane] = a0; part[(wave * 3 + 1) * 64 + lane] = a1; part[(wave * 3 + 2) * 64 + lane] = a2;
    __syncthreads();
    if (wave < 3) { float s = ((const GAS float*)b_mod)[l * 6144 + col];
#pragma unroll
        for (int w8 = 0; w8 < 8; ++w8) s += part[(w8 * 3 + wave) * 64 + lane];
        MODV[(l * 3 + wave) * 6144 + col] = s; }
    __syncthreads();
}

__device__ __forceinline__ void norm_mod_row(const float* xrow, const float* g, const float* shift, const float* scale, bf16_t* orow, int lane, f32x4 (&v)[4]) {
    float s = 0.f;
#pragma unroll
    for (int j = 0; j < 4; ++j) { v[j] = ((const GAS f32x4*)xrow)[lane + 64 * j]; s += (v[j].x * v[j].x + v[j].y * v[j].y) + (v[j].z * v[j].z + v[j].w * v[j].w); }
    const float rstd = rsqrtf(wave_sum(s) * (1.f / DM) + 1e-6f);
#pragma unroll
    for (int j = 0; j < 4; ++j) { const f32x4 gg = ((const GAS f32x4*)g)[lane + 64 * j], sh = ((const GAS f32x4*)shift)[lane + 64 * j], sc = ((const GAS f32x4*)scale)[lane + 64 * j];
        v[j] = (v[j] * rstd * gg) * (sc + 1.f) + sh;
        u32x2 o; o.x = pk2(v[j].x, v[j].y); o.y = pk2(v[j].z, v[j].w); ((GAS u32x2*)orow)[lane + 64 * j] = o; }
}
struct GridOrder {
    int nM, nN, nwg, G, c, skipctx;
    __device__ __forceinline__ void init(int nM_, int nN_, int G_, int c_, int skip_) { nM = nM_; nN = nN_; nwg = nM * nN; G = G_; c = c_; skipctx = skip_; }
    __device__ __forceinline__ bool tile(long L, int& pm, int& pn) const {
        if (L >= nwg) return false;
        int wgid = (int)L; { const int q = nwg / 8, r = nwg % 8, xcd = wgid % 8, off = wgid / 8; wgid = (xcd < r ? xcd * (q + 1) : r * (q + 1) + (xcd - r) * q) + off; }
        const int nig = 8 * nN, gid = wgid / nig, fm = gid * 8, gsz = (nM - fm) < 8 ? (nM - fm) : 8;
        pm = fm + ((wgid % nig) % gsz); pn = (wgid % nig) / gsz;
        if (skipctx) pm = (pm >> 5) * 33 + 1 + (pm & 31);
        return true;
    }
    __device__ __forceinline__ bool next(int i, pg8::Unit& u) const { u.z = 0; u.pad = 0; u.aoff = 0; u.boff = 0; return tile((long)i * G + c, u.pm, u.pn); }
};
struct QuadOrder : GridOrder {
    __device__ __forceinline__ bool next(int i, pg8::Unit& u) const { u.z = i & 3; u.pad = 0; u.aoff = (long)u.z * (long)SZ512; u.boff = (long)u.z * 1024 * 512 * 2; return tile((long)(i >> 2) * G + c, u.pm, u.pn); }
};
template <int NJ> struct S5Order {
    int G, c;
    __device__ __forceinline__ bool next(int i, pg8::Unit& u) const { const int L = i * G + c; if (L >= 32 * 3 * NJ) return false; const int g = L / (3 * NJ), r = L % (3 * NJ); u.pm = 3 * g + r / NJ; u.pn = g * NJ + r % NJ; u.z = g; u.pad = 0; u.aoff = 0; u.boff = 0; return true; }
};
struct MoeOrder {
    int G, c, ntiles; const LAS int* texp;
    __device__ __forceinline__ bool next(int i, pg8::Unit& u) const { const int L = i * G + c; if (L >= ntiles * 4) return false; const int mt = L >> 2, j = L & 3; u.pm = mt; u.pn = texp[mt] * 4 + j; u.z = j; u.pad = 0; u.aoff = 0; u.boff = 0; return true; }
};

#define EPI_ARGS const f32x4 (&acc)[2][2][4][2], const pg8::Unit& u, int wr, int wc, int fr, int fq
#define EPI_LOOP_BEGIN  _Pragma("unroll") for (int ai = 0; ai < 2; ++ai) _Pragma("unroll") for (int m = 0; m < 4; ++m) { const int r = u.pm * 256 + ai * 128 + wr * 64 + m * 16 + fr; \
                        _Pragma("unroll") for (int bj = 0; bj < 2; ++bj) { const int ct = bj * 128 + wc * 32 + 8 * fq; f32x4 v0 = acc[ai][bj][m][0], v1 = acc[ai][bj][m][1];
#define EPI_LOOP_END    } }
__device__ __forceinline__ u32x4 pack8(f32x4 v0, f32x4 v1) { u32x4 w; w.x = pg8::cvt_pk_bf16(v0[0], v0[1]); w.y = pg8::cvt_pk_bf16(v0[2], v0[3]); w.z = pg8::cvt_pk_bf16(v1[0], v1[1]); w.w = pg8::cvt_pk_bf16(v1[2], v1[3]); return w; }

struct EpiG1 {
    unsigned char* ws; const float* b_gates; const float* b_gate;
    __device__ __forceinline__ void operator()(EPI_ARGS) const {
        const int pn = u.pn; unsigned char* A = ws + WS_A;
        if (pn < 2) {
            bf16_t* UH = (bf16_t*)(A + A_UH);
            EPI_LOOP_BEGIN
                const int cu = pn * 256 + ct, g = cu >> 4, ch0 = cu & 15; const int b = r / SB, s = r - b * SB, cc = s >> 5, j = s & 31;
                *(GAS u32x4*)(UH + ((size_t)(g * S5RP + b * S5NC + cc)) * 768 + j * 16 + ch0) = pack8(v0, v1);
            EPI_LOOP_END
        } else if (pn < 18) {
            const int bi = (pn - 2) >> 1; bf16_t* P = (bf16_t*)(A + A_P512 + (size_t)bi * SZ512); const float sc = (bi == 0) ? 0.125f * LOG2E : (bi == 4 ? 0.08838834764831845f : 1.f);
            EPI_LOOP_BEGIN
                *(GAS u32x4*)(P + (size_t)r * 512 + (pn & 1) * 256 + ct) = pack8(v0 * sc, v1 * sc);
            EPI_LOOP_END
        } else if (pn == 18) {
            EPI_LOOP_BEGIN
                bf16_t* P = (bf16_t*)(A + (bj ? A_GQV : A_GQK));
                *(GAS u32x4*)(P + (size_t)r * 128 + wc * 32 + 8 * fq) = pack8(v0, v1);
            EPI_LOOP_END
        } else if (pn == 19) {
            float* MLG = (float*)(A + A_MLG);
            if (wc == 0 && fq < 2) {
#pragma unroll
                for (int ai = 0; ai < 2; ++ai)
#pragma unroll
                    for (int m = 0; m < 4; ++m) { const int r = u.pm * 256 + ai * 128 + wr * 64 + m * 16 + fr; f32x4 v0 = acc[ai][0][m][0], v1 = acc[ai][0][m][1];
                        const int c0 = 8 * fq;
                        v0 = v0 + *(const GAS f32x4*)(b_gates + c0); v1 = v1 + *(const GAS f32x4*)(b_gates + c0 + 4);
                        v1 = (f32x4){log_sigmoidf_(v1[0]), log_sigmoidf_(v1[1]), log_sigmoidf_(v1[2]), log_sigmoidf_(v1[3])};
                        *(GAS f32x4*)(MLG + (size_t)r * 16 + c0) = v0; *(GAS f32x4*)(MLG + (size_t)r * 16 + c0 + 4) = v1; }
            }
        } else {
            bf16_t* GT = (bf16_t*)(A + A_GATE); const int gc0 = (pn - 20) * 256;
            f32x4 bb[2][2];
#pragma unroll
            for (int bj = 0; bj < 2; ++bj) { const int c = gc0 + bj * 128 + wc * 32 + 8 * fq; bb[bj][0] = *(const GAS f32x4*)(b_gate + c); bb[bj][1] = *(const GAS f32x4*)(b_gate + c + 4); }
            EPI_LOOP_BEGIN
                const int c = gc0 + ct;
                v0 = v0 + bb[bj][0]; v1 = v1 + bb[bj][1];
                v0 = (f32x4){sigmoidf_(v0[0]), sigmoidf_(v0[1]), sigmoidf_(v0[2]), sigmoidf_(v0[3])}; v1 = (f32x4){sigmoidf_(v1[0]), sigmoidf_(v1[1]), sigmoidf_(v1[2]), sigmoidf_(v1[3])};
                *(GAS u32x4*)(GT + (size_t)r * 4096 + c) = pack8(v0, v1);
            EPI_LOOP_END
        }
    }
};
struct EpiS5State {
    float* SST;
    __device__ __forceinline__ void operator()(EPI_ARGS) const {
        const int g = u.z, mi = u.pm - 3 * g;
        EPI_LOOP_BEGIN
            const int rr = mi * 256 + (r - u.pm * 256);
            if (rr < S5ROWS) { float* p = SST + ((size_t)g * S5ROWS + rr) * 256 + ct; *(f32x4*)p = v0; *(GAS f32x4*)(p + 4) = v1; }
        EPI_LOOP_END
    }
};
struct EpiS5Out {
    bf16_t* Z;
    __device__ __forceinline__ void operator()(EPI_ARGS) const {
        const int g = u.z, mi = u.pm - 3 * g, nj = u.pn - 2 * g;
        EPI_LOOP_BEGIN
            const int rr = mi * 256 + (r - u.pm * 256);
            if (rr < S5ROWS) { const int n = nj * 256 + ct, j = n >> 4, ch0 = n & 15, b = rr / S5NC, cc = rr - b * S5NC; const size_t row = (size_t)b * SB + cc * 32 + j;
                v0 = (f32x4){gelu_tanh(v0[0]), gelu_tanh(v0[1]), gelu_tanh(v0[2]), gelu_tanh(v0[3])}; v1 = (f32x4){gelu_tanh(v1[0]), gelu_tanh(v1[1]), gelu_tanh(v1[2]), gelu_tanh(v1[3])};
                *(GAS u32x4*)(Z + row * 512 + g * 16 + ch0) = pack8(v0, v1); }
        EPI_LOOP_END
    }
};
struct EpiGlu {
    const bf16_t* Z; bf16_t* YA; const float* b_glu;
    __device__ __forceinline__ void operator()(EPI_ARGS) const {
        f32x4 bb[2][2];
#pragma unroll
        for (int bj = 0; bj < 2; ++bj) { const int c = u.pn * 256 + bj * 128 + wc * 32 + 8 * fq; bb[bj][0] = *(const GAS f32x4*)(b_glu + c); bb[bj][1] = *(const GAS f32x4*)(b_glu + c + 4); }
#pragma unroll
        for (int ai = 0; ai < 2; ++ai) { u32x4 zz[4][2];
#pragma unroll
            for (int m = 0; m < 4; ++m)
#pragma unroll
                for (int bj = 0; bj < 2; ++bj) { const int r = u.pm * 256 + ai * 128 + wr * 64 + m * 16 + fr, c = u.pn * 256 + bj * 128 + wc * 32 + 8 * fq; zz[m][bj] = *(const GAS u32x4*)(Z + (size_t)r * 512 + c); }
#pragma unroll
            for (int m = 0; m < 4; ++m)
#pragma unroll
                for (int bj = 0; bj < 2; ++bj) { const int r = u.pm * 256 + ai * 128 + wr * 64 + m * 16 + fr, c = u.pn * 256 + bj * 128 + wc * 32 + 8 * fq; const u32x4 z = zz[m][bj];
                    f32x4 v0 = acc[ai][bj][m][0] + bb[bj][0], v1 = acc[ai][bj][m][1] + bb[bj][1];
                    v0 = (f32x4){bflo(z.x) * sigmoidf_(v0[0]), bfhi(z.x) * sigmoidf_(v0[1]), bflo(z.y) * sigmoidf_(v0[2]), bfhi(z.y) * sigmoidf_(v0[3])};
                    v1 = (f32x4){bflo(z.z) * sigmoidf_(v1[0]), bfhi(z.z) * sigmoidf_(v1[1]), bflo(z.w) * sigmoidf_(v1[2]), bfhi(z.w) * sigmoidf_(v1[3])};
                    *(GAS u32x4*)(YA + (size_t)r * 512 + c) = pack8(v0, v1); } }
    }
};
struct EpiMerge {
    const bf16_t* GT; float* MSUM; bf16_t* HB;
    __device__ __forceinline__ void operator()(EPI_ARGS) const {
        const int z = u.z;
#pragma unroll
        for (int ai = 0; ai < 2; ++ai)
#pragma unroll
          for (int mh = 0; mh < 2; ++mh) { u32x4 gq[2][2]; f32x4 ms[2][2][2];
#pragma unroll
            for (int ml = 0; ml < 2; ++ml)
#pragma unroll
                for (int bj = 0; bj < 2; ++bj) { const int m = mh * 2 + ml, r = u.pm * 256 + ai * 128 + wr * 64 + m * 16 + fr, c = u.pn * 256 + bj * 128 + wc * 32 + 8 * fq;
                    gq[ml][bj] = *(const GAS u32x4*)(GT + (size_t)r * 4096 + z * 1024 + c);
                    if (z > 0) { const float* mp = MSUM + (size_t)r * 1024 + c; ms[ml][bj][0] = *(const f32x4*)mp; ms[ml][bj][1] = *(const GAS f32x4*)(mp + 4); } }
#pragma unroll
            for (int ml = 0; ml < 2; ++ml)
#pragma unroll
                for (int bj = 0; bj < 2; ++bj) { const int m = mh * 2 + ml, r = u.pm * 256 + ai * 128 + wr * 64 + m * 16 + fr, c = u.pn * 256 + bj * 128 + wc * 32 + 8 * fq; const u32x4 g4 = gq[ml][bj];
                    f32x4 v0 = acc[ai][bj][m][0] * (f32x4){bflo(g4.x), bfhi(g4.x), bflo(g4.y), bfhi(g4.y)}, v1 = acc[ai][bj][m][1] * (f32x4){bflo(g4.z), bfhi(g4.z), bflo(g4.w), bfhi(g4.w)};
                    if (z > 0) { v0 = v0 + ms[ml][bj][0]; v1 = v1 + ms[ml][bj][1]; }
                    float* mp = MSUM + (size_t)r * 1024 + c;
                    if (z < 3) { *(f32x4*)mp = v0; *(GAS f32x4*)(mp + 4) = v1; } else *(GAS u32x4*)(HB + (size_t)r * 1024 + c) = pack8(v0, v1); } }
    }
};
struct EpiWout {
    float* out; float* xctx; const float* modl; float mul;
    __device__ __forceinline__ void operator()(EPI_ARGS) const {
        const int r00 = u.pm * 256; const float* mrow = modl + modsel(r00) * 6144 + 2 * 1024; float* xbase = xrow_ptr(out, xctx, r00);
        f32x4 mm[2][2];
#pragma unroll
        for (int bj = 0; bj < 2; ++bj) { const int c = u.pn * 256 + bj * 128 + wc * 32 + 8 * fq; mm[bj][0] = *(const GAS f32x4*)(mrow + c) * mul; mm[bj][1] = *(const GAS f32x4*)(mrow + c + 4) * mul; }
#pragma unroll
        for (int ai = 0; ai < 2; ++ai)
#pragma unroll
          for (int mh = 0; mh < 2; ++mh) { f32x4 xx[2][2][2];
#pragma unroll
            for (int ml = 0; ml < 2; ++ml)
#pragma unroll
                for (int bj = 0; bj < 2; ++bj) { const int m = mh * 2 + ml, rl = ai * 128 + wr * 64 + m * 16 + fr, c = u.pn * 256 + bj * 128 + wc * 32 + 8 * fq; const float* xp = xbase + (size_t)rl * DM + c;
                    xx[ml][bj][0] = *(const f32x4*)xp; xx[ml][bj][1] = *(const GAS f32x4*)(xp + 4); }
#pragma unroll
            for (int ml = 0; ml < 2; ++ml)
#pragma unroll
                for (int bj = 0; bj < 2; ++bj) { const int m = mh * 2 + ml, rl = ai * 128 + wr * 64 + m * 16 + fr, c = u.pn * 256 + bj * 128 + wc * 32 + 8 * fq; float* xp = xbase + (size_t)rl * DM + c;
                    *(f32x4*)xp = xx[ml][bj][0] + mm[bj][0] * acc[ai][bj][m][0]; *(GAS f32x4*)(xp + 4) = xx[ml][bj][1] + mm[bj][1] * acc[ai][bj][m][1]; } }
    }
};
struct EpiMoe1 {
    bf16_t* MH;
    __device__ __forceinline__ void operator()(EPI_ARGS) const {
        EPI_LOOP_BEGIN
            const int hcol = u.z * 128 + (ct >> 1);
            f32x4 hh = (f32x4){v0[0] * sigmoidf_(v0[0]) * v1[0], v0[1] * sigmoidf_(v0[1]) * v1[1], v0[2] * sigmoidf_(v0[2]) * v1[2], v0[3] * sigmoidf_(v0[3]) * v1[3]};
            u32x2 w; w.x = pg8::cvt_pk_bf16(hh[0], hh[1]); w.y = pg8::cvt_pk_bf16(hh[2], hh[3]);
            *(GAS u32x2*)(MH + (size_t)r * 512 + hcol) = w;
        EPI_LOOP_END
    }
};
struct EpiMoe2 {
    bf16_t* MY;
    __device__ __forceinline__ void operator()(EPI_ARGS) const {
        EPI_LOOP_BEGIN
            *(GAS u32x4*)(MY + (size_t)r * 1024 + u.z * 256 + ct) = pack8(v0, v1);
        EPI_LOOP_END
    }
};

constexpr int MLS = 136;
__device__ __forceinline__ void lds_gemm128(f32x4 (&acc)[2][4], const LAS bf16_t* A, const LAS bf16_t* Bt, int wm, int wn, int fr, int fq) {
#pragma unroll
    for (int ks = 0; ks < 4; ++ks) {
        bf16x8 a[2], b[4];
#pragma unroll
        for (int mi = 0; mi < 2; ++mi) a[mi] = *(const LAS bf16x8*)(A + (32 * wm + 16 * mi + fr) * MLS + ks * 32 + fq * 8);
#pragma unroll
        for (int ni = 0; ni < 4; ++ni) b[ni] = *(const LAS bf16x8*)(Bt + (64 * wn + 16 * ni + fr) * MLS + ks * 32 + fq * 8);
#pragma unroll
        for (int mi = 0; mi < 2; ++mi)
#pragma unroll
            for (int ni = 0; ni < 4; ++ni) acc[mi][ni] = __builtin_amdgcn_mfma_f32_16x16x32_bf16(a[mi], b[ni], acc[mi][ni], 0, 0, 0);
    }
}
__device__ __forceinline__ int ml_idx(int b, int d, int h, int cc) { return ((b * 2 + d) * 4 + h) * MLNC + cc; }
__device__ __forceinline__ int ml_prev(int d, int cc) { if (d == 0) return cc - 1; if (cc == 1) return -1; if (cc == 0) return 1; if (cc == 65) return 0; return cc + 1; }
__device__ __forceinline__ int ml_order(int d, int s) { if (d == 0) return s; if (s == 0) return 1; if (s == 1) return 0; return 67 - s; }

__device__ __forceinline__ float ml_gates(const GAS float* MLG, int r0, int d, int h, LAS float* lf_s, LAS float* ev, LAS float* fs, LAS float* wv) {
    const int tid = otid(); float li = 0.f, lf = 0.f;
    if (tid < 128) { li = MLG[(size_t)(r0 + tid) * 16 + d * 8 + h]; lf = MLG[(size_t)(r0 + tid) * 16 + d * 8 + 4 + h]; lf_s[tid] = lf; }
    __syncthreads();
    float tot = 0.f;
    if (tid < 128) { float c = 0.f; for (int i = 0; i < 128; ++i) { const float x = lf_s[i]; tot += x; if (d == 0 ? (i <= tid) : (i >= tid)) c += x; }
        ev[tid] = c; fs[tid] = c - li; wv[tid] = __expf(tot - c + li); }
    __syncthreads();
    float t2 = 0.f; for (int i = 0; i < 128; ++i) t2 += lf_s[i];
    return t2;
}
__device__ __forceinline__ void ml_stage_a(int b, int h, int cc, int d, const GAS bf16_t* MLK, const GAS bf16_t* MLV, const GAS float* MLG, GAS bf16_t* CST, GAS float* NST, GAS float* DEC, LAS unsigned char* lds) {
    const int tid = otid(), lane = tid & 63, wid = tid >> 6, wm = wid >> 1, wn = wid & 1, fr = lane & 15, fq = lane >> 4;
    LAS bf16_t* VT = (LAS bf16_t*)lds; LAS bf16_t* KT = (LAS bf16_t*)(lds + 128 * MLS * 2);
    LAS float* lf_s = (LAS float*)(lds + 4 * 128 * MLS * 2); LAS float* ev = lf_s + 128; LAS float* fs = ev + 128; LAS float* wv = fs + 128;
    const int r0 = b * SB + cc * MLC; const int idx = ml_idx(b, d, h, cc);
    const float tot = ml_gates(MLG, r0, d, h, lf_s, ev, fs, wv);
    if (tid == 0) DEC[idx] = __expf(tot);
#pragma unroll
    for (int i = 0; i < 4; ++i) { const int q = tid + 512 * i, t = q >> 4, c8 = (q & 15) * 8;
        const u32x4 kv = *(const GAS u32x4*)(MLK + (size_t)(r0 + t) * 512 + h * 128 + c8), vv = *(const GAS u32x4*)(MLV + (size_t)(r0 + t) * 512 + h * 128 + c8); const float w = wv[t];
        const unsigned kk[4] = {kv.x, kv.y, kv.z, kv.w}, vw[4] = {vv.x, vv.y, vv.z, vv.w};
#pragma unroll
        for (int e = 0; e < 4; ++e) { KT[(c8 + 2 * e) * MLS + t] = (bf16_t)(kk[e] & 0xffffu); KT[(c8 + 2 * e + 1) * MLS + t] = (bf16_t)(kk[e] >> 16);
            VT[(c8 + 2 * e) * MLS + t] = (bf16_t)f2bf(bflo(vw[e]) * w); VT[(c8 + 2 * e + 1) * MLS + t] = (bf16_t)f2bf(bfhi(vw[e]) * w); } }
    __syncthreads();
    f32x4 acc[2][4];
#pragma unroll
    for (int mi = 0; mi < 2; ++mi)
#pragma unroll
        for (int ni = 0; ni < 4; ++ni) acc[mi][ni] = (f32x4){0.f, 0.f, 0.f, 0.f};
    lds_gemm128(acc, VT, KT, wm, wn, fr, fq);
    GAS bf16_t* G = CST + (size_t)idx * 16384;
#pragma unroll
    for (int mi = 0; mi < 2; ++mi)
#pragma unroll
        for (int ni = 0; ni < 4; ++ni)
#pragma unroll
            for (int rg = 0; rg < 4; ++rg) G[(32 * wm + 16 * mi + 4 * fq + rg) * 128 + 64 * wn + 16 * ni + fr] = (bf16_t)f2bf(acc[mi][ni][rg]);
    if (tid < 128) { float s = 0.f; for (int t = 0; t < 128; ++t) s += wv[t] * bf2f(KT[tid * MLS + t]); NST[(size_t)idx * 128 + tid] = s; }
    __syncthreads();
}
__device__ __forceinline__ void ml_scan(GAS bf16_t* CST, GAS float* NST, const GAS float* DEC, int gtid, int nthreads) {
    for (int q = gtid; q < 16 * 8192; q += nthreads) {
        const int seq = q >> 13, e2 = (q & 8191) * 2, b = seq >> 3, d = (seq >> 2) & 1, h = seq & 3; float s0 = 0.f, s1 = 0.f;
        for (int s = 0; s < MLNC; s += 22) { unsigned g[22]; float dc[22];
#pragma unroll
            for (int k = 0; k < 22; ++k) { const int idx = ml_idx(b, d, h, ml_order(d, s + k)); g[k] = *(const GAS unsigned*)(CST + (size_t)idx * 16384 + e2); dc[k] = DEC[idx]; }
#pragma unroll
            for (int k = 0; k < 22; ++k) { const int idx = ml_idx(b, d, h, ml_order(d, s + k)); s0 = dc[k] * s0 + bflo(g[k]); s1 = dc[k] * s1 + bfhi(g[k]); *(GAS unsigned*)(CST + (size_t)idx * 16384 + e2) = pk2(s0, s1); } }
    }
    for (int q = gtid; q < 16 * 128; q += nthreads) {
        const int seq = q >> 7, e = q & 127, b = seq >> 3, d = (seq >> 2) & 1, h = seq & 3; float s0 = 0.f;
        for (int s = 0; s < MLNC; ++s) { const int idx = ml_idx(b, d, h, ml_order(d, s)); s0 = DEC[idx] * s0 + NST[(size_t)idx * 128 + e]; NST[(size_t)idx * 128 + e] = s0; }
    }
}
__device__ __forceinline__ void ml_stage_c(int b, int h, int cc, const GAS bf16_t* MLQ, const GAS bf16_t* MLK, const GAS bf16_t* MLV, const GAS bf16_t* MLO, const GAS float* MLG, const GAS bf16_t* CST, const GAS float* NST,
                                           const GAS float* g_norm, GAS bf16_t* YM, LAS unsigned char* lds) {
    const int tid = otid(), lane = tid & 63, wid = tid >> 6, wm = wid >> 1, wn = wid & 1, fr = lane & 15, fq = lane >> 4;
    LAS bf16_t* Qs = (LAS bf16_t*)lds; LAS bf16_t* Ks = (LAS bf16_t*)(lds + 128 * MLS * 2); LAS bf16_t* VT = (LAS bf16_t*)(lds + 2 * 128 * MLS * 2); LAS bf16_t* Cp = (LAS bf16_t*)(lds + 3 * 128 * MLS * 2);
    LAS float* lf_s = (LAS float*)(lds + 4 * 128 * MLS * 2); LAS float* ev = lf_s + 128; LAS float* fs = ev + 128; LAS float* wv = fs + 128; LAS float* npv = wv + 128; LAS float* den = npv + 128; LAS float* part = den + 128;
    const int r0 = b * SB + cc * MLC;
    f32x4 hsum[2][4];
#pragma unroll
    for (int mi = 0; mi < 2; ++mi)
#pragma unroll
        for (int ni = 0; ni < 4; ++ni) hsum[mi][ni] = (f32x4){0.f, 0.f, 0.f, 0.f};
    for (int d = 0; d < 2; ++d) {
        (void)ml_gates(MLG, r0, d, h, lf_s, ev, fs, wv);
        const int pc = ml_prev(d, cc); const GAS bf16_t* Cg = (pc >= 0) ? CST + (size_t)ml_idx(b, d, h, pc) * 16384 : nullptr;
        if (tid < 128) npv[tid] = (pc >= 0) ? NST[(size_t)ml_idx(b, d, h, pc) * 128 + tid] : 0.f;
#pragma unroll
        for (int i = 0; i < 4; ++i) { const int q = tid + 512 * i, t = q >> 4, c8 = (q & 15) * 8;
            *(LAS u32x4*)(Qs + t * MLS + c8) = *(const GAS u32x4*)(MLQ + (size_t)(r0 + t) * 512 + h * 128 + c8);
            *(LAS u32x4*)(Ks + t * MLS + c8) = *(const GAS u32x4*)(MLK + (size_t)(r0 + t) * 512 + h * 128 + c8);
            *(LAS u32x4*)(Cp + t * MLS + c8) = Cg ? *(const GAS u32x4*)(Cg + t * 128 + c8) : (u32x4){0u, 0u, 0u, 0u};
            const u32x4 vv = *(const GAS u32x4*)(MLV + (size_t)(r0 + t) * 512 + h * 128 + c8); const unsigned vw[4] = {vv.x, vv.y, vv.z, vv.w};
#pragma unroll
            for (int e = 0; e < 4; ++e) { VT[(c8 + 2 * e) * MLS + t] = (bf16_t)(vw[e] & 0xffffu); VT[(c8 + 2 * e + 1) * MLS + t] = (bf16_t)(vw[e] >> 16); } }
        __syncthreads();
        f32x4 acc[2][4];
#pragma unroll
        for (int mi = 0; mi < 2; ++mi)
#pragma unroll
            for (int ni = 0; ni < 4; ++ni) acc[mi][ni] = (f32x4){0.f, 0.f, 0.f, 0.f};
        lds_gemm128(acc, Qs, Ks, wm, wn, fr, fq);
        __syncthreads();
#pragma unroll
        for (int mi = 0; mi < 2; ++mi)
#pragma unroll
            for (int ni = 0; ni < 4; ++ni) { const int s = 64 * wn + 16 * ni + fr; const float fss = fs[s];
#pragma unroll
                for (int rg = 0; rg < 4; ++rg) { const int t = 32 * wm + 16 * mi + 4 * fq + rg; const bool ok = (d == 0) ? (s <= t) : (s >= t);
                    const float p = ok ? acc[mi][ni][rg] * __expf(ev[t] - fss) : 0.f; Ks[t * MLS + s] = (bf16_t)f2bf(p); } }
#pragma unroll
        for (int i = 0; i < 4; ++i) { const int q = tid + 512 * i, t = q >> 4, c8 = (q & 15) * 8; const float sc = __expf(ev[t]);
            u32x4 qv = *(LAS u32x4*)(Qs + t * MLS + c8);
            qv.x = pk2(bflo(qv.x) * sc, bfhi(qv.x) * sc); qv.y = pk2(bflo(qv.y) * sc, bfhi(qv.y) * sc); qv.z = pk2(bflo(qv.z) * sc, bfhi(qv.z) * sc); qv.w = pk2(bflo(qv.w) * sc, bfhi(qv.w) * sc);
            *(LAS u32x4*)(Qs + t * MLS + c8) = qv; }
        __syncthreads();
        { const int t = tid >> 2, q4 = tid & 3; float s = 0.f;
            for (int j = 0; j < 32; ++j) { const int c = q4 * 32 + j; s += bf2f(Ks[t * MLS + c]) + bf2f(Qs[t * MLS + c]) * npv[c]; }
            s += __shfl_xor(s, 1); s += __shfl_xor(s, 2); if (q4 == 0) den[t] = s; }
#pragma unroll
        for (int mi = 0; mi < 2; ++mi)
#pragma unroll
            for (int ni = 0; ni < 4; ++ni) acc[mi][ni] = (f32x4){0.f, 0.f, 0.f, 0.f};
        lds_gemm128(acc, Ks, VT, wm, wn, fr, fq);
        lds_gemm128(acc, Qs, Cp, wm, wn, fr, fq);
        __syncthreads();
#pragma unroll
        for (int mi = 0; mi < 2; ++mi)
#pragma unroll
            for (int rg = 0; rg < 4; ++rg) { const int t = 32 * wm + 16 * mi + 4 * fq + rg; const float inv = 1.f / fmaxf(fabsf(den[t]), 1.f);
#pragma unroll
                for (int ni = 0; ni < 4; ++ni) hsum[mi][ni][rg] += acc[mi][ni][rg] * inv; }
        __syncthreads();
    }
#pragma unroll
    for (int mi = 0; mi < 2; ++mi)
#pragma unroll
        for (int rg = 0; rg < 4; ++rg) { float s = 0.f;
#pragma unroll
            for (int ni = 0; ni < 4; ++ni) s += hsum[mi][ni][rg] * hsum[mi][ni][rg];
            s += __shfl_xor(s, 1); s += __shfl_xor(s, 2); s += __shfl_xor(s, 4); s += __shfl_xor(s, 8);
            if (fr == 0) part[(32 * wm + 16 * mi + 4 * fq + rg) * 2 + wn] = s; }
    __syncthreads();
#pragma unroll
    for (int mi = 0; mi < 2; ++mi)
#pragma unroll
        for (int rg = 0; rg < 4; ++rg) { const int t = 32 * wm + 16 * mi + 4 * fq + rg; const float rstd = rsqrtf((part[t * 2] + part[t * 2 + 1]) * (1.f / 128.f) + 1e-6f);
#pragma unroll
            for (int ni = 0; ni < 4; ++ni) { const int c = h * 128 + 64 * wn + 16 * ni + fr; const float o = bf2f(MLO[(size_t)(r0 + t) * 512 + c]);
                YM[(size_t)(r0 + t) * 512 + c] = (bf16_t)f2bf(hsum[mi][ni][rg] * rstd * g_norm[c] * sigmoidf_(o)); } }
    __syncthreads();
}
__device__ __forceinline__ void gqa_prep_item(int row, int hs, GAS bf16_t* GQQ, GAS bf16_t* GQK, const GAS float* gq, const GAS float* gk) {
    GAS bf16_t* p = (hs < 8) ? GQQ + (size_t)row * 512 + hs * 64 : GQK + (size_t)row * 128 + (hs - 8) * 64; const GAS float* g = (hs < 8) ? gq : gk;
    float x[64]; float ss = 0.f;
#pragma unroll
    for (int i = 0; i < 8; ++i) { const u32x4 v = *(const GAS u32x4*)(p + 8 * i); x[8 * i] = bflo(v.x); x[8 * i + 1] = bfhi(v.x); x[8 * i + 2] = bflo(v.y); x[8 * i + 3] = bfhi(v.y); x[8 * i + 4] = bflo(v.z); x[8 * i + 5] = bfhi(v.z); x[8 * i + 6] = bflo(v.w); x[8 * i + 7] = bfhi(v.w); }
#pragma unroll
    for (int i = 0; i < 64; ++i) ss += x[i] * x[i];
    const float rstd = rsqrtf(ss * (1.f / 64.f) + 1e-6f);
#pragma unroll
    for (int i = 0; i < 64; ++i) x[i] = x[i] * rstd * g[i];
    const int b = row / SB, s = row - b * SB;
    if (s >= CTX) { const int n = s - CTX; const float pr = (float)(n >> 6), pc = (float)(n & 63);
#pragma unroll
        for (int i = 0; i < 16; ++i) { const float fr_ = exp2f(-(float)i * (13.287712379549449f / 16.f));
            float sn, cs; __sincosf(pr * fr_, &sn, &cs); const float a1 = x[i], a2 = x[16 + i]; x[i] = a1 * cs - a2 * sn; x[16 + i] = a1 * sn + a2 * cs;
            __sincosf(pc * fr_, &sn, &cs); const float b1 = x[32 + i], b2 = x[48 + i]; x[32 + i] = b1 * cs - b2 * sn; x[48 + i] = b1 * sn + b2 * cs; } }
    const float sc = (hs < 8) ? 0.125f * LOG2E : 1.f;
#pragma unroll
    for (int i = 0; i < 8; ++i) { u32x4 o; o.x = pk2(x[8 * i] * sc, x[8 * i + 1] * sc); o.y = pk2(x[8 * i + 2] * sc, x[8 * i + 3] * sc); o.z = pk2(x[8 * i + 4] * sc, x[8 * i + 5] * sc); o.w = pk2(x[8 * i + 6] * sc, x[8 * i + 7] * sc); *(GAS u32x4*)(p + 8 * i) = o; }
}

struct RsLinear { __device__ __forceinline__ int operator()(int t) const { return 64 * t; } };
struct RsNa { int w0; __device__ __forceinline__ int operator()(int t) const { return t < 4 ? 64 * t : CTX + 64 * (w0 + t - 4); } };
struct NaHook { static constexpr bool ON = true; const LAS float* tab; int r0, w0;
    __device__ __forceinline__ void operator()(f32x16& C0, f32x16& C1, int t, int wid, int r32, int hi, float mhat) const {
        if (t < 4) {
#pragma unroll
            for (int q = 0; q < 16; ++q) { C0[q] -= mhat; C1[q] -= mhat; }
            return; }
        const int r = r0 + (wid >> 1), c = 32 * (wid & 1) + r32, kr = w0 + t - 4;
        const int rs = min(max(r - 4, 0), 120), cs = min(max(c - 8, 0), 48);
        const float NEG = -INFINITY;
        if (kr < rs || kr >= rs + 8) {
#pragma unroll
            for (int q = 0; q < 16; ++q) { C0[q] = NEG; C1[q] = NEG; }
            return; }
        const LAS float* tl = tab + (kr - r + 7) * 31 + (15 - c) + 4 * hi; const int kb = 4 * hi - cs;
#pragma unroll
        for (int q = 0; q < 16; ++q) { const int ko = (q & 3) + 8 * (q >> 2);
            C0[q] = ((unsigned)(kb + ko) < 16u) ? C0[q] + (tl[ko] - mhat) : NEG; C1[q] = ((unsigned)(kb + ko + 32) < 16u) ? C1[q] + (tl[ko + 32] - mhat) : NEG; }
    }
};
__device__ __forceinline__ void na_phase(int l, int vcu, int G, const float* rpb_l, unsigned char* ws, char* lds) {
    const bf16_t* NAQ = (const bf16_t*)(ws + WS_A + A_P512), *NAK = NAQ + (size_t)RT * 512, *NAV = NAK + (size_t)RT * 512; bf16_t* YB = (bf16_t*)(ws + WS_B + SZ512);
    float* tabf = (float*)(lds + NA_TAB_OFF);
    { const int t0 = otid(); float tv[8];
#pragma unroll
      for (int j = 0; j < 8; ++j) { const int i = t0 + 512 * j; tv[j] = ((const GAS float*)rpb_l)[i < 8 * 465 ? i : 0]; }
#pragma unroll
      for (int j = 0; j < 8; ++j) { const int i = t0 + 512 * j; if (i < 8 * 465) tabf[i] = tv[j] * LOG2E; } }
    __syncthreads();
    const int nu = 512 + (l == 0 ? 16 : 0);
    for (int u = vcu; u < nu; u += G) {
        using bf = attn_body::bf16;
        if (u < 512) { const int b = u >> 8, h = (u >> 5) & 7, qb = u & 31; const int r0 = 4 * qb, w0 = min(max(r0 - 4, 0), 116);
            const size_t qrow = (size_t)b * SB + CTX + 256 * qb, krow = (size_t)b * SB;
            NaHook hk{(const LAS float*)(tabf + h * 465), r0, w0};
            attn_body::attn_unit<8>((const bf*)(NAQ + qrow * 512 + h * 64), 512, (const bf*)(NAK + krow * 512 + h * 64), (const bf*)(NAV + krow * 512 + h * 64), 512, RsNa{w0}, 16, (bf*)(YB + qrow * 512 + h * 64), 512, lds, hk);
        } else { const int b = (u - 512) >> 3, h = (u - 512) & 7; const size_t krow = (size_t)b * SB;
            attn_body::attn_unit<8>((const bf*)(NAQ + krow * 512 + h * 64), 512, (const bf*)(NAK + krow * 512 + h * 64), (const bf*)(NAV + krow * 512 + h * 64), 512, RsLinear{}, 4, (bf*)(YB + krow * 512 + h * 64), 512, lds, attn_body::NoHook{});
        }
    }
}
__device__ __forceinline__ void gqa_phase(int l, int vcu, int G, unsigned char* ws, char* lds) {
    const bf16_t* GQQ = (const bf16_t*)(ws + WS_A + A_P512 + 7 * SZ512), *GQK = (const bf16_t*)(ws + WS_A + A_GQK), *GQV = (const bf16_t*)(ws + WS_A + A_GQV); bf16_t* YD = (bf16_t*)(ws + WS_B + 3 * SZ512);
    const int nu = 512 + (l == 0 ? 16 : 0);
    for (int u = vcu; u < nu; u += G) {
        using bf = attn_body::bf16;
        if (u < 512) { const int hq = u & 3, qb = (u >> 2) & 31, kvh = (u >> 7) & 1, b = u >> 8, h = kvh * 4 + hq;
            const size_t qrow = (size_t)b * SB + CTX + 256 * qb, krow = (size_t)b * SB;
            attn_body::attn_unit<8>((const bf*)(GQQ + qrow * 512 + h * 64), 512, (const bf*)(GQK + krow * 128 + kvh * 64), (const bf*)(GQV + krow * 128 + kvh * 64), 128, RsLinear{}, SB / 64, (bf*)(YD + qrow * 512 + h * 64), 512, lds, attn_body::NoHook{});
        } else { const int b = (u - 512) >> 3, h = (u - 512) & 7, kvh = h >> 2; const size_t krow = (size_t)b * SB;
            attn_body::attn_unit<8>((const bf*)(GQQ + krow * 512 + h * 64), 512, (const bf*)(GQK + krow * 128 + kvh * 64), (const bf*)(GQV + krow * 128 + kvh * 64), 128, RsLinear{}, 4, (bf*)(YD + krow * 512 + h * 64), 512, lds, attn_body::NoHook{});
        }
    }
}

__device__ __forceinline__ int s5_order(int d, int s) { if (d == 0) return s; return s < 8 ? 7 - s : 271 - s; }
__device__ __forceinline__ void s5_scan(const GAS float* SST, const GAS float* AL, GAS bf16_t* UH, int gtid, int nthreads) {
    for (int q = gtid; q < 2 * 2 * 32 * 64; q += nthreads) {
        const int p = q & 63, g = (q >> 6) & 31, d = (q >> 11) & 1, b = q >> 12;
        const float ar = AL[((d * 32 + g) * 64 + p) * 2], ai = AL[((d * 32 + g) * 64 + p) * 2 + 1]; float hr = 0.f, hi_ = 0.f;
        const GAS float* sp = SST + ((size_t)g * S5ROWS + b * S5NC) * 256 + d * 128 + 2 * p; GAS bf16_t* up = UH + ((size_t)g * S5RP + b * S5NC) * 768 + 512 + d * 128 + 2 * p;
        for (int s = 0; s < S5NC; s += 33) { f32x2 x[33];
#pragma unroll
            for (int k = 0; k < 33; ++k) x[k] = *(const GAS f32x2*)(sp + (size_t)s5_order(d, s + k) * 256);
#pragma unroll
            for (int k = 0; k < 33; ++k) { const int cc = s5_order(d, s + k); *(GAS unsigned*)(up + (size_t)cc * 768) = pk2(hr, hi_);
                const float nr = ar * hr - ai * hi_ + x[k].x, ni = ar * hi_ + ai * hr + x[k].y; hr = nr; hi_ = ni; } }
    }
}

__device__ __forceinline__ void route_token(const float (&lg)[32], const GAS float* b_router, int& e0, int& e1, float& w0, float& w1) {
    float s[32], sel[32];
#pragma unroll
    for (int i = 0; i < 32; ++i) { s[i] = sigmoidf_(lg[i]); sel[i] = s[i] + b_router[i]; }
    float best = -INFINITY; int grp = 0;
#pragma unroll
    for (int gi = 0; gi < 8; ++gi) { const float a = sel[4 * gi], b = sel[4 * gi + 1], c = sel[4 * gi + 2], d = sel[4 * gi + 3];
        const float m1 = fmaxf(fmaxf(a, b), fmaxf(c, d)); const float sum = a + b + c + d, mn = fminf(fminf(a, b), fminf(c, d));
        float x0 = a, x1 = b, x2 = c, x3 = d; bool rem = false; float sec = -INFINITY;
        if (!rem && x0 == m1) rem = true; else sec = fmaxf(sec, x0);
        if (!rem && x1 == m1) rem = true; else sec = fmaxf(sec, x1);
        if (!rem && x2 == m1) rem = true; else sec = fmaxf(sec, x2);
        if (!rem && x3 == m1) rem = true; else sec = fmaxf(sec, x3);
        (void)sum; (void)mn;
        const float sc = m1 + sec; if (sc > best) { best = sc; grp = gi; } }
    float v[4]; float sv[4];
#pragma unroll
    for (int j = 0; j < 4; ++j) { v[j] = 0.f; sv[j] = 0.f; }
#pragma unroll
    for (int gi = 0; gi < 8; ++gi) if (gi == grp) {
#pragma unroll
        for (int j = 0; j < 4; ++j) { v[j] = sel[4 * gi + j]; sv[j] = s[4 * gi + j]; } }
    int i0 = 0; float m = v[0];
#pragma unroll
    for (int j = 1; j < 4; ++j) if (v[j] > m) { m = v[j]; i0 = j; }
    int i1 = -1; float m2 = -INFINITY;
#pragma unroll
    for (int j = 0; j < 4; ++j) if (j != i0 && v[j] > m2) { m2 = v[j]; i1 = j; }
    float s0 = 0.f, s1 = 0.f;
#pragma unroll
    for (int j = 0; j < 4; ++j) { if (j == i0) s0 = sv[j]; if (j == i1) s1 = sv[j]; }
    e0 = grp * 4 + i0; e1 = grp * 4 + i1; const float inv = 1.f / (s0 + s1); w0 = s0 * inv; w1 = s1 * inv;
}
__device__ __forceinline__ int moe_offsets(const unsigned* cnt, LAS int* offs, LAS int* texp) {
    if (otid() == 0) { int o = 0; for (int e = 0; e < 32; ++e) { offs[e] = o; const int c = (int)__hip_atomic_load(cnt + e, __ATOMIC_RELAXED, __HIP_MEMORY_SCOPE_AGENT); const int pt = (c + 255) >> 8; for (int t = 0; t < pt; ++t) texp[(o >> 8) + t] = e; o += pt * 256; } offs[32] = o; }
    __syncthreads();
    return offs[32] >> 8;
}
#ifndef MK_MULTI
#define MK_MULTI 0
#endif
constexpr int NPHASE = 26;
#ifndef PHMASK
#define PHMASK 0xffff
#endif
#define HAS(k) (((PHMASK) >> (k)) & 1)
#ifndef SUBMASK
#define SUBMASK 0xff
#endif
#define SUB(k) (((SUBMASK) >> (k)) & 1)
#ifndef DUPMASK
#define DUPMASK 0
#endif
#define DUPN(k) ((((DUPMASK) >> (k)) & 1) ? 2 : 1)
struct Args { const float* in[34]; float* out; unsigned char* ws; int ph_lo, ph_hi; };
enum { I_X = 0, I_C, I_CTX, I_CCTX, I_WMOD, I_BMOD, I_GN1, I_GN2, I_WIN, I_LAMRE, I_LAMIM, I_LOGDT, I_BRE, I_BIM, I_CRE, I_CIM, I_S5D, I_WGLU, I_BGLU, I_RPB, I_MLBG, I_MLNORM, I_GQQN, I_GQKN,
       I_WBR, I_WGATE, I_BGATE, I_WOUT, I_WROUTER, I_BROUTER, I_W1, I_W3, I_W2, I_GFINAL };

__device__ __forceinline__ void norm_mod_vals(f32x4 (&v)[4], const float* g, const float* shift, const float* scale, bf16_t* orow, int lane) {
    float s = 0.f;
#pragma unroll
    for (int j = 0; j < 4; ++j) s += (v[j].x * v[j].x + v[j].y * v[j].y) + (v[j].z * v[j].z + v[j].w * v[j].w);
    const float rstd = rsqrtf(wave_sum(s) * (1.f / DM) + 1e-6f);
#pragma unroll
    for (int j = 0; j < 4; ++j) { const f32x4 gg = ((const GAS f32x4*)g)[lane + 64 * j], sh = ((const GAS f32x4*)shift)[lane + 64 * j], sc = ((const GAS f32x4*)scale)[lane + 64 * j];
        v[j] = (v[j] * rstd * gg) * (sc + 1.f) + sh;
        u32x2 o; o.x = pk2(v[j].x, v[j].y); o.y = pk2(v[j].z, v[j].w); ((GAS u32x2*)orow)[lane + 64 * j] = o; }
}

__device__ __forceinline__ const char* kseg() { const char* ka = (const char*)__builtin_amdgcn_kernarg_segment_ptr(); asm volatile("" : "+s"(ka)); return ka; }
__device__ __forceinline__ const float* kin(int i) { return *(const float* const*)(kseg() + 8 * i); }
__device__ __forceinline__ float* kout() { return *(float* const*)(kseg() + 8 * 34); }
__device__ __forceinline__ unsigned char* kws() { return *(unsigned char* const*)(kseg() + 8 * 35); }
template <int K, int L>
__device__ __forceinline__ void run_phase(unsigned char* ws, float* out, const int vcu, const int G, const int bx, LAS unsigned char* lds, unsigned char* lds_raw) {
    const int NGW = G * 8, NTH = G * 512;
    float* xctx = (float*)(ws + WS_XCTX); unsigned* ctl = (unsigned*)(ws + WS_CTL);
    float* MODV = (float*)(ws + WS_MODV); bf16_t* HB = (bf16_t*)(ws + WS_HB);
    unsigned char* RA = ws + WS_A; unsigned char* RB = ws + WS_B; unsigned char* RC = ws + WS_C;
    LAS int* offs = (LAS int*)(lds + MISC_OFF + 64); LAS int* texp = (LAS int*)(lds + MISC_OFF + 256);
    GAS int* TOK_E = (GAS int*)(ws + WS_ROUTE); GAS float* TOK_W = (GAS float*)(ws + WS_ROUTE + (size_t)RT * 8); GAS int* TOK_DST = (GAS int*)(ws + WS_ROUTE + (size_t)RT * 16);
    {
        const int tid = otid(), lane = tid & 63, wave = __builtin_amdgcn_readfirstlane(tid >> 6), gw = vcu * 8 + wave, gtid = vcu * 512 + tid;
        constexpr int l = L, k = K; constexpr bool last = (l == 1);
        const float* modl = MODV + l * 3 * 6144;
        if constexpr (HAS(0) && (k == 0 || (k == 13 && l == 0))) {
            const int lc = (k == 0) ? 0 : 1;
            if (k == 0) {
                const GAS f32x4* x4 = (const GAS f32x4*)kin(I_X); GAS f32x4* o4 = (GAS f32x4*)out;
                for (int i = gtid; i < NB * SEQ * DM / 4; i += NTH) o4[i] = x4[i];
                const GAS f32x4* c4 = (const GAS f32x4*)kin(I_CTX); GAS f32x4* xc4 = (GAS f32x4*)xctx;
                for (int i = gtid; i < NB * CTX * DM / 4; i += NTH) xc4[i] = c4[i];
            } else {
                const bf16_t* MY = (const bf16_t*)(RA + A_MY);
                for (int row = gw; row < RT; row += NGW) {
                    float* xr = xrow_ptr(out, xctx, row); const int ms = modsel(row); const float* m5 = modl + ms * 6144 + 5 * 1024;
                    const int d0 = TOK_DST[row * 2], d1 = TOK_DST[row * 2 + 1]; const float w0 = TOK_W[row * 2], w1 = TOK_W[row * 2 + 1];
                    f32x4 v[4];
#pragma unroll
                    for (int j = 0; j < 4; ++j) { const u32x2 y0 = ((const GAS u32x2*)(MY + (size_t)d0 * 1024))[lane + 64 * j], y1 = ((const GAS u32x2*)(MY + (size_t)d1 * 1024))[lane + 64 * j];
                        const f32x4 f = (f32x4){w0 * bflo(y0.x) + w1 * bflo(y1.x), w0 * bfhi(y0.x) + w1 * bfhi(y1.x), w0 * bflo(y0.y) + w1 * bflo(y1.y), w0 * bfhi(y0.y) + w1 * bfhi(y1.y)};
                        v[j] = ((const GAS f32x4*)xr)[lane + 64 * j] + ((const GAS f32x4*)m5)[lane + 64 * j] * f; ((GAS f32x4*)xr)[lane + 64 * j] = v[j]; }
                    const float* mn = MODV + 3 * 6144 + ms * 6144;
                    norm_mod_vals(v, kin(I_GN1) + DM, mn, mn + 1024, HB + (size_t)row * DM, lane);
                }
            }
            if (k == 0) {
                LAS float* scs = (LAS float*)lds; LAS float* part = (LAS float*)(lds + 12288);
                { const GAS float* cp = (const GAS float*)kin(I_C); const GAS float* ccp = (const GAS float*)kin(I_CCTX); float cv[6];
#pragma unroll
                  for (int j = 0; j < 6; ++j) { const int i = tid + 512 * j; cv[j] = (i < 2048) ? cp[i] : ccp[i - 2048]; }
#pragma unroll
                  for (int j = 0; j < 6; ++j) scs[tid + 512 * j] = cv[j] * sigmoidf_(cv[j]); }
                __syncthreads();
                for (int it = G - 1 - vcu; it < 192; it += G) modv_item(it, kin(I_WMOD), kin(I_BMOD), MODV, scs, part, wave, lane);
                __syncthreads();
            }
            for (int rep_ = 0; rep_ < DUPN(13); ++rep_) {
            for (int it = vcu; it < 256; it += G)
                s5_precompute(lc, it >> 3, it & 7, kin(I_LAMRE), kin(I_LAMIM), kin(I_LOGDT), kin(I_BRE), kin(I_BIM), kin(I_CRE), kin(I_CIM), kin(I_S5D), ws, lds);
            conv_layer_weights(kin(I_WIN) + (size_t)lc * 1024 * 4880, kin(I_WGATE) + (size_t)lc * 1024 * 4096, kin(I_WBR) + (size_t)lc * 4 * 512 * 1024, kin(I_WOUT) + (size_t)lc * 1024 * 1024,
                               kin(I_WGLU) + (size_t)lc * 512 * 512, ws, (LAS float*)(lds + wave * 8448), gw, NGW, lane);
            }
        } else if constexpr (HAS(1) && k == 1) {
            for (int row = gw; row < RT; row += NGW) { const float* mn = MODV + modsel(row) * 6144; f32x4 v[4];
                norm_mod_row(xrow_ptr(out, xctx, row), kin(I_GN1), mn, mn + 1024, HB + (size_t)row * DM, lane, v); }
        } else if constexpr (HAS(2) && k == 2) {
            pg8::Gemm g{HB, (const bf16_t*)(ws + WS_WG1), 1024, 1024, 1024}; GridOrder S; S.init(NTILE, 36, G, bx, 0);
            EpiG1 E{ws, kin(I_MLBG) + l * 16, kin(I_BGATE) + l * 4096};
            for (int rep_ = 0; rep_ < DUPN(1); ++rep_) pg8::gemm_phase(lds, g, S, E);
        } else if constexpr (HAS(3) && k == 3) {
            if (SUB(0)) { pg8::Gemm g{(const bf16_t*)(RA + A_UH), (const bf16_t*)(ws + WS_S5BS), 768, 512, 512}; S5Order<1> S{G, vcu}; EpiS5State E{(float*)(RC + C_SST)}; for (int rep_ = 0; rep_ < DUPN(2); ++rep_) pg8::gemm_phase(lds, g, S, E); }
            if (SUB(1)) { const GAS bf16_t* MLK = (const GAS bf16_t*)(RA + A_P512 + 4 * SZ512), *MLV = (const GAS bf16_t*)(RA + A_P512 + 5 * SZ512);
              for (int it = G - 1 - vcu; it < 1056; it += G) { const int cc = it % MLNC, h = (it / MLNC) & 3, d = (it / (MLNC * 4)) & 1, b = it / (MLNC * 8);
                  for (int rep_ = 0; rep_ < DUPN(3); ++rep_) ml_stage_a(b, h, cc, d, MLK, MLV, (const GAS float*)(RA + A_MLG), (GAS bf16_t*)(RC + C_CST), (GAS float*)(RC + C_NST), (GAS float*)(RC + C_DEC), lds); } }
            if (SUB(2)) { GAS bf16_t* GQQ = (GAS bf16_t*)(RA + A_P512 + 7 * SZ512); GAS bf16_t* GQK = (GAS bf16_t*)(RA + A_GQK);
              for (int q = gtid; q < RT * 10; q += NTH) gqa_prep_item(q / 10, q % 10, GQQ, GQK, (const GAS float*)(kin(I_GQQN) + l * 64), (const GAS float*)(kin(I_GQKN) + l * 64)); }
            __syncthreads();
            if (SUB(3)) for (int rep_ = 0; rep_ < DUPN(4); ++rep_) na_phase(l, vcu, G, kin(I_RPB) + l * 3720, ws, (char*)lds_raw);
        } else if constexpr (HAS(4) && k == 4) {
            s5_scan((const GAS float*)(RC + C_SST), (const GAS float*)(ws + WS_S5AL), (GAS bf16_t*)(RA + A_UH), gtid, NTH);
            ml_scan((GAS bf16_t*)(RC + C_CST), (GAS float*)(RC + C_NST), (const GAS float*)(RC + C_DEC), gtid, NTH);
            for (int rep_ = 0; rep_ < DUPN(5); ++rep_) gqa_phase(l, vcu, G, ws, (char*)lds_raw);
        } else if constexpr (HAS(5) && k == 5) {
            pg8::Gemm g{(const bf16_t*)(RA + A_UH), (const bf16_t*)(ws + WS_S5BO), 768, 768, 768}; S5Order<2> S{G, vcu}; EpiS5Out E{(bf16_t*)(RB + B_Z)}; for (int rep_ = 0; rep_ < DUPN(6); ++rep_) pg8::gemm_phase(lds, g, S, E);
        } else if constexpr (HAS(6) && k == 6) {
            if (SUB(0)) { pg8::Gemm g{(const bf16_t*)(RB + B_Z), (const bf16_t*)(ws + WS_WGLU), 512, 512, 512}; GridOrder S; S.init(last ? 64 : NTILE, 2, G, bx, last ? 1 : 0);
              EpiGlu E{(const bf16_t*)(RB + B_Z), (bf16_t*)RB, kin(I_BGLU) + l * 512}; for (int rep_ = 0; rep_ < DUPN(7); ++rep_) pg8::gemm_phase(lds, g, S, E); }
            if (SUB(1)) { const GAS bf16_t* P = (const GAS bf16_t*)(RA + A_P512); const int ncc = last ? 64 : 66, nit = NB * 4 * ncc;
              for (int it = G - 1 - vcu; it < nit; it += G) { const int cc = it % ncc + (last ? 2 : 0), h = (it / ncc) & 3, b = it / (ncc * 4);
                  for (int rep_ = 0; rep_ < DUPN(8); ++rep_) ml_stage_c(b, h, cc, P + 3 * (size_t)RT * 512, P + 4 * (size_t)RT * 512, P + 5 * (size_t)RT * 512, P + 6 * (size_t)RT * 512, (const GAS float*)(RA + A_MLG), (const GAS bf16_t*)(RC + C_CST), (const GAS float*)(RC + C_NST),
                             (const GAS float*)(kin(I_MLNORM) + l * 512), (GAS bf16_t*)(RB + 2 * SZ512), lds); } }
        } else if constexpr (HAS(7) && k == 7) {
            pg8::Gemm g{(const bf16_t*)RB, (const bf16_t*)(ws + WS_WBR), 512, 512, 512}; QuadOrder S; S.init(last ? 64 : NTILE, 4, G, bx, last ? 1 : 0);
            EpiMerge E{(const bf16_t*)(RA + A_GATE), (float*)(RA + A_MSUM), HB}; for (int rep_ = 0; rep_ < DUPN(9); ++rep_) pg8::gemm_phase(lds, g, S, E);
        } else if constexpr (HAS(8) && k == 8) {
            { pg8::Gemm g{HB, (const bf16_t*)(ws + WS_WOUT), 1024, 1024, 1024}; GridOrder S; S.init(last ? 64 : NTILE, 4, G, bx, last ? 1 : 0);
              EpiWout E{out, xctx, modl, 1.f}; pg8::gemm_phase(lds, g, S, E); if (DUPN(15) == 2) { EpiWout E0{out, xctx, modl, 0.f}; pg8::gemm_phase(lds, g, S, E0); } }
            for (int rep_ = 0; rep_ < DUPN(10); ++rep_) conv_moe_weights(kin(I_W1) + (size_t)l * 32 * 1024 * 512, kin(I_W3) + (size_t)l * 32 * 1024 * 512, kin(I_W2) + (size_t)l * 32 * 512 * 1024, ws, (LAS float*)(lds + wave * 8448), gw, NGW, lane);
        } else if constexpr (HAS(9) && k == 9) {
            LAS float* wl = (LAS float*)lds;
            { const GAS f32x4* wr4 = (const GAS f32x4*)kin(I_WROUTER);
              f32x4 wv[16];
#pragma unroll
              for (int j = 0; j < 16; ++j) wv[j] = wr4[tid + 512 * j];
#pragma unroll
              for (int j = 0; j < 16; ++j) { const int i4 = tid + 512 * j, kk = i4 >> 3, e4 = (i4 & 7) * 4; *(LAS f32x4*)(wl + ((kk & 3) * 256 + (kk >> 2)) * 36 + e4) = wv[j]; } }
            __syncthreads();
            unsigned* cnt = ctl + CW_CNT + 64 * l;
            for (int row = gw; row < RT; row += NGW) {
                const int ms = modsel(row); if (last && ms == 2) continue;
                const float* mn = modl + ms * 6144; f32x4 v[4];
                norm_mod_row(xrow_ptr(out, xctx, row), kin(I_GN2) + l * DM, mn + 3 * 1024, mn + 4 * 1024, HB + (size_t)row * DM, lane, v);
                float lg[32];
#pragma unroll
                for (int i = 0; i < 32; ++i) lg[i] = 0.f;
#pragma unroll
                for (int j = 0; j < 4; ++j)
#pragma unroll
                    for (int e = 0; e < 4; ++e) { const float hv = v[j][e]; const LAS f32x4* wp = (const LAS f32x4*)(wl + (e * 256 + lane + 64 * j) * 36);
#pragma unroll
                        for (int q = 0; q < 8; ++q) { const f32x4 w = wp[q]; lg[4 * q] += hv * w.x; lg[4 * q + 1] += hv * w.y; lg[4 * q + 2] += hv * w.z; lg[4 * q + 3] += hv * w.w; } }
#pragma unroll
                for (int i = 0; i < 32; ++i) lg[i] = wave_sum(lg[i]);
                int e0, e1; float w0, w1; route_token(lg, (const GAS float*)kin(I_BROUTER), e0, e1, w0, w1);
                if (lane == 0) { const int p0 = (int)atomicAdd(cnt + e0, 1u), p1 = (int)atomicAdd(cnt + e1, 1u);
                    TOK_E[row * 2] = e0; TOK_E[row * 2 + 1] = e1; TOK_W[row * 2] = w0; TOK_W[row * 2 + 1] = w1; TOK_DST[row * 2] = p0; TOK_DST[row * 2 + 1] = p1; }
            }
            __syncthreads();
        } else if constexpr (HAS(10) && k == 10) {
            (void)moe_offsets(ctl + CW_CNT + 64 * l, offs, texp);
            bf16_t* MBUF = (bf16_t*)(RA + A_MBUF);
            for (int row = gw; row < RT; row += NGW) {
                if (last && modsel(row) == 2) continue;
                const int d0 = offs[TOK_E[row * 2]] + TOK_DST[row * 2], d1 = offs[TOK_E[row * 2 + 1]] + TOK_DST[row * 2 + 1];
                const u32x4 v0 = ((const GAS u32x4*)(HB + (size_t)row * DM))[lane], v1 = ((const GAS u32x4*)(HB + (size_t)row * DM))[lane + 64];
                ((GAS u32x4*)(MBUF + (size_t)d0 * DM))[lane] = v0; ((GAS u32x4*)(MBUF + (size_t)d0 * DM))[lane + 64] = v1;
                ((GAS u32x4*)(MBUF + (size_t)d1 * DM))[lane] = v0; ((GAS u32x4*)(MBUF + (size_t)d1 * DM))[lane + 64] = v1;
                if (lane == 0) { TOK_DST[row * 2] = d0; TOK_DST[row * 2 + 1] = d1; }
            }
            __syncthreads();
        } else if constexpr (HAS(11) && k == 11) {
            const int nt = moe_offsets(ctl + CW_CNT + 64 * l, offs, texp);
            pg8::Gemm g{(const bf16_t*)(RA + A_MBUF), (const bf16_t*)(RA + A_W13), 1024, 1024, 1024}; MoeOrder S{G, vcu, nt, texp}; EpiMoe1 E{(bf16_t*)(RA + A_MH)}; for (int rep_ = 0; rep_ < DUPN(11); ++rep_) pg8::gemm_phase(lds, g, S, E);
        } else if constexpr (HAS(12) && k == 12) {
            const int nt = moe_offsets(ctl + CW_CNT + 64 * l, offs, texp);
            pg8::Gemm g{(const bf16_t*)(RA + A_MH), (const bf16_t*)(RA + A_W2), 512, 512, 512}; MoeOrder S{G, vcu, nt, texp}; EpiMoe2 E{(bf16_t*)(RA + A_MY)}; for (int rep_ = 0; rep_ < DUPN(12); ++rep_) pg8::gemm_phase(lds, g, S, E);
        } else if constexpr (HAS(13) && k == 13) {
            const bf16_t* MY = (const bf16_t*)(RA + A_MY);
            for (int row = gw; row < RT; row += NGW) {
                const int ms = modsel(row); if (ms == 2) continue;
                float* xr = xrow_ptr(out, xctx, row); const float* m5 = modl + ms * 6144 + 5 * 1024;
                const int d0 = TOK_DST[row * 2], d1 = TOK_DST[row * 2 + 1]; const float w0 = TOK_W[row * 2], w1 = TOK_W[row * 2 + 1];
                f32x4 v[4]; float s = 0.f;
#pragma unroll
                for (int j = 0; j < 4; ++j) { const u32x2 y0 = ((const GAS u32x2*)(MY + (size_t)d0 * 1024))[lane + 64 * j], y1 = ((const GAS u32x2*)(MY + (size_t)d1 * 1024))[lane + 64 * j];
                    const f32x4 f = (f32x4){w0 * bflo(y0.x) + w1 * bflo(y1.x), w0 * bfhi(y0.x) + w1 * bfhi(y1.x), w0 * bflo(y0.y) + w1 * bflo(y1.y), w0 * bfhi(y0.y) + w1 * bfhi(y1.y)};
                    v[j] = ((const GAS f32x4*)xr)[lane + 64 * j] + ((const GAS f32x4*)m5)[lane + 64 * j] * f; s += (v[j].x * v[j].x + v[j].y * v[j].y) + (v[j].z * v[j].z + v[j].w * v[j].w); }
                const float rstd = rsqrtf(wave_sum(s) * (1.f / DM) + 1e-6f);
#pragma unroll
                for (int j = 0; j < 4; ++j) ((GAS f32x4*)xr)[lane + 64 * j] = v[j] * rstd * ((const GAS f32x4*)kin(I_GFINAL))[lane + 64 * j];
            }
        }
    }
}

__global__ void __launch_bounds__(512, 2) hybrid_fwd(Args a) {
    LAS unsigned char* lds = (LAS unsigned char*)lds_raw;
    { const int t0 = threadIdx.x; if ((t0 & 63) == 0) ((volatile LAS int*)(lds + WMAP_OFF))[(unsigned)__builtin_amdgcn_s_getreg((5 << 11) | 4) & 63u] = t0 >> 6; }
    __syncthreads();
    const int tid0 = otid();
    const int G = gridDim.x, bx = blockIdx.x, vcu = (G % 8 == 0) ? (bx % 8) * (G / 8) + bx / 8 : bx;
    volatile LAS unsigned* MISC = (volatile LAS unsigned*)(lds + MISC_OFF);
    if (tid0 < 16) MISC[tid0] = 0u;
    __syncthreads();
    const int lo = a.ph_lo, hi = a.ph_hi;
    XcdBarrier bar; bar.bar = (unsigned*)(a.ws + WS_CTL) + CW_BAR; bar.x = 0; bar.st = MISC;
    if (hi - lo > 1) bar = xcd_barrier_post((unsigned*)(a.ws + WS_CTL) + CW_BAR, MISC);
#define SEAM(ph) do { if ((ph) + 1 < hi) { if constexpr ((ph) == 0) { __threadfence(); cg::this_grid().sync(); __builtin_amdgcn_fence(__ATOMIC_ACQUIRE, "agent"); asm volatile("s_waitcnt vmcnt(0)" ::: "memory"); __syncthreads(); } else { xcd_barrier(bar); if (DUPN(14) == 2) xcd_barrier(bar); } } } while (0)
#define PH(ph, K, L) do { if (lo <= (ph) && (ph) < hi) { run_phase<K, L>(a.ws, a.out, vcu, G, bx, lds, lds_raw); SEAM(ph); } } while (0)
    PH(0, 0, 0); PH(1, 1, 0);
    PH(2, 2, 0); PH(3, 3, 0); PH(4, 4, 0); PH(5, 5, 0); PH(6, 6, 0); PH(7, 7, 0); PH(8, 8, 0); PH(9, 9, 0); PH(10, 10, 0); PH(11, 11, 0); PH(12, 12, 0); PH(13, 13, 0);
    PH(14, 2, 1); PH(15, 3, 1); PH(16, 4, 1); PH(17, 5, 1); PH(18, 6, 1); PH(19, 7, 1); PH(20, 8, 1); PH(21, 9, 1); PH(22, 10, 1); PH(23, 11, 1); PH(24, 12, 1); PH(25, 13, 1);
#undef PH
#undef SEAM
}

extern "C" void kernel_launch(void* const* d_in, const int* in_sizes, int n_in, void* d_out, int out_size, void* d_ws, size_t ws_size, hipStream_t stream) {
    static int grid = 0;
    if (grid == 0) {
        if (n_in != 34 || out_size != NB * SEQ * DM || ws_size < WS_END) { fprintf(stderr, "kernel_launch: unexpected problem (n_in %d out %d ws %zu, need ws >= %zu)\n", n_in, out_size, ws_size, (size_t)WS_END); grid = -1; return; }
        int dev = 0, cus = 0, per_cu = 0;
        hipGetDevice(&dev); hipDeviceGetAttribute(&cus, hipDeviceAttributeMultiprocessorCount, dev);
        if (hipFuncSetAttribute((const void*)hybrid_fwd, hipFuncAttributeMaxDynamicSharedMemorySize, LDS_BYTES) != hipSuccess) { fprintf(stderr, "kernel_launch: hipFuncSetAttribute failed\n"); grid = -1; return; }
        if (hipOccupancyMaxActiveBlocksPerMultiprocessor(&per_cu, (const void*)hybrid_fwd, 512, LDS_BYTES) != hipSuccess || per_cu < 1) { fprintf(stderr, "kernel_launch: occupancy query says %d blocks per CU\n", per_cu); grid = -1; return; }
        (void)hipGetLastError();
        grid = cus;
    }
    if (grid < 0) return;
    hipMemsetAsync((char*)d_ws + WS_CTL, 0, CTL_BYTES, stream);
    Args a{};
    for (int i = 0; i < 34; ++i) a.in[i] = (const float*)d_in[i];
    a.out = (float*)d_out; a.ws = (unsigned char*)d_ws;
#if MK_MULTI
    for (int ph = 0; ph < NPHASE; ++ph) { a.ph_lo = ph; a.ph_hi = ph + 1; void* args[] = {&a};
        hipError_t e = hipLaunchCooperativeKernel((const void*)hybrid_fwd, dim3(grid), dim3(512), args, LDS_BYTES, stream);
        if (e != hipSuccess) { fprintf(stderr, "launch %d failed: %s\n", ph, hipGetErrorString(e)); break; } }
#else
    a.ph_lo = 0; a.ph_hi = NPHASE; void* args[] = {&a};
    hipError_t e = hipLaunchCooperativeKernel((const void*)hybrid_fwd, dim3(grid), dim3(512), args, LDS_BYTES, stream);
    if (e != hipSuccess) fprintf(stderr, "cooperative launch failed: %s (grid %d)\n", hipGetErrorString(e), grid);
#endif
}
```
